# Optimizing an MI355X kernel written in HIP

```python
import math
import jax, jax.numpy as jnp
from jax import lax
import numpy as np

D_MODEL = 1024
BATCH = 4
SEQ = 4096
DEPTH = 4

CHUNK = 64
S5_WIDTH = 512
S5_GROUP = 16
S5_GROUPS = S5_WIDTH // S5_GROUP
S5_STATE = 64
DT_MIN = 1e-3
DT_MAX = 1e-1
MLA_HEADS = 8
QK_NOPE = 64
QK_ROPE = 32
V_HEAD = 64
Q_LORA = 384
KV_LORA = 256
ROPE_THETA = 10000.0
Q_BLOCK = 128
SGU_WIDTH = 512
SGU_GROUPS = 4
SGU_CHUNK = 128
N_BRANCH = 3
BRANCH_WIDTH = 512
FF_HIDDEN = -(-8 * D_MODEL // (3 * 256)) * 256
DEEPNORM_ALPHA = (2 * DEPTH) ** 0.25
DEEPNORM_BETA = (8 * DEPTH) ** -0.25
LN_EPS = 1e-5
RMS_EPS = 1e-6
NEG_INF = -1e30
IN_WIDTHS = (S5_WIDTH, Q_LORA, KV_LORA, QK_ROPE, SGU_WIDTH, SGU_WIDTH, N_BRANCH * D_MODEL)
IN_OFFSETS = tuple(int(o) for o in np.cumsum(IN_WIDTHS)[:-1])
IN_WIDTH = sum(IN_WIDTHS)

kernel_name = 'hybrid_s5_mla_sgu_deepnorm_adaln'


def layer_norm(x, g, b):
    xf = x.astype(jnp.float32)
    mu = jnp.mean(xf, axis=-1, keepdims=True)
    var = jnp.mean(jnp.square(xf - mu), axis=-1, keepdims=True)
    return ((xf - mu) * lax.rsqrt(var + LN_EPS)).astype(x.dtype) * g + b


def rms_norm(x, g):
    xf = x.astype(jnp.float32)
    return (xf * lax.rsqrt(jnp.mean(xf * xf, axis=-1, keepdims=True) + RMS_EPS)).astype(x.dtype) * g


def rope(x, cos, sin):
    x1, x2 = jnp.split(x, 2, axis=-1)
    return jnp.concatenate([x1 * cos - x2 * sin, x2 * cos + x1 * sin], axis=-1)


def _complex_affine_combine(left, right):
    ar1, ai1, br1, bi1 = left
    ar2, ai2, br2, bi2 = right
    return (ar2 * ar1 - ai2 * ai1,
            ar2 * ai1 + ai2 * ar1,
            ar2 * br1 - ai2 * bi1 + br2,
            ar2 * bi1 + ai2 * br1 + bi2)


def s5_mixer(u, lam_re, lam_im, log_dt, b_re, b_im, c_re, c_im, d, w_glu, b_glu):
    f32 = jnp.float32
    bsz, seq, _ = u.shape
    uf = u.astype(f32)
    ug = uf.reshape(bsz, seq, S5_GROUPS, S5_GROUP)
    dt = jnp.exp(log_dt.astype(f32))[:, None]
    lr = lam_re.astype(f32)
    li = lam_im.astype(f32)
    mag = jnp.exp(lr * dt)
    a_re = mag * jnp.cos(li * dt)
    a_im = mag * jnp.sin(li * dt)
    den = lr * lr + li * li
    f_re = ((a_re - 1.0) * lr + a_im * li) / den
    f_im = (a_im * lr - (a_re - 1.0) * li) / den
    br = b_re.astype(f32)
    bi = b_im.astype(f32)
    bb_re = f_re[..., None] * br - f_im[..., None] * bi
    bb_im = f_re[..., None] * bi + f_im[..., None] * br
    bu_re = jnp.einsum('bsgc,gpc->bsgp', ug, bb_re)
    bu_im = jnp.einsum('bsgc,gpc->bsgp', ug, bb_im)
    a_re_t = jnp.broadcast_to(a_re, (1, seq) + a_re.shape)
    a_im_t = jnp.broadcast_to(a_im, (1, seq) + a_im.shape)
    _, _, h_re, h_im = lax.associative_scan(
        _complex_affine_combine, (a_re_t, a_im_t, bu_re, bu_im), axis=1)
    y = (jnp.einsum('bsgp,gcp->bsgc', h_re, c_re.astype(f32))
         - jnp.einsum('bsgp,gcp->bsgc', h_im, c_im.astype(f32)))
    y = y.reshape(bsz, seq, S5_WIDTH) + d.astype(f32) * uf
    z = jax.nn.gelu(y)
    out = z * jax.nn.sigmoid(z @ w_glu.astype(f32) + b_glu.astype(f32))
    return out.astype(u.dtype)


def mla_mixer(cq, ckv, k_pe, q_norm, w_q_up, kv_norm, w_kv_up, cos, sin):
    bsz, seq, _ = cq.shape
    q = (rms_norm(cq, q_norm) @ w_q_up).reshape(bsz, seq, MLA_HEADS, QK_NOPE + QK_ROPE)
    q_nope = q[..., :QK_NOPE]
    q_pe = rope(q[..., QK_NOPE:], cos[:, None, :], sin[:, None, :])
    kv = (rms_norm(ckv, kv_norm) @ w_kv_up).reshape(bsz, seq, MLA_HEADS, QK_NOPE + V_HEAD)
    k_nope = kv[..., :QK_NOPE]
    v = kv[..., QK_NOPE:]
    k_pe = rope(k_pe, cos, sin)
    n_blk = seq // Q_BLOCK
    scale = (QK_NOPE + QK_ROPE) ** -0.5
    q_nope_b = q_nope.reshape(bsz, n_blk, Q_BLOCK, MLA_HEADS, QK_NOPE).transpose(1, 0, 2, 3, 4)
    q_pe_b = q_pe.reshape(bsz, n_blk, Q_BLOCK, MLA_HEADS, QK_ROPE).transpose(1, 0, 2, 3, 4)
    key_chunk = jnp.arange(seq) // CHUNK

    def attend_block(args):
        blk, qn, qp = args
        s = (jnp.einsum('bqhd,bkhd->bhqk', qn, k_nope)
             + jnp.einsum('bqhr,bkr->bhqk', qp, k_pe))
        s = s.astype(jnp.float32) * scale
        q_chunk = (blk * Q_BLOCK + jnp.arange(Q_BLOCK)) // CHUNK
        mask = key_chunk[None, :] <= q_chunk[:, None]
        s = jnp.where(mask, s, NEG_INF)
        p = jax.nn.softmax(s, axis=-1).astype(v.dtype)
        return jnp.einsum('bhqk,bkhd->bqhd', p, v)

    o = lax.map(attend_block, (jnp.arange(n_blk), q_nope_b, q_pe_b))
    return o.transpose(1, 0, 2, 3, 4).reshape(bsz, seq, MLA_HEADS * V_HEAD)


def sgu_mixer(u, v, ln_g, ln_b, w_s, b_s):
    bsz, seq, _ = u.shape
    u = jax.nn.gelu(u)
    v = layer_norm(jax.nn.gelu(v), ln_g, ln_b)
    n_chunk = seq // SGU_CHUNK
    vg = v.reshape(bsz, n_chunk, SGU_CHUNK, SGU_GROUPS, SGU_WIDTH // SGU_GROUPS)
    pos_chunk = jnp.arange(SGU_CHUNK) // CHUNK
    mask = pos_chunk[None, :] <= pos_chunk[:, None]
    w = jnp.where(mask[None], w_s, 0.0)
    mixed = jnp.einsum('gij,bnjgc->bnigc', w, vg) + b_s.T[:, :, None]
    return u * mixed.reshape(bsz, seq, SGU_WIDTH)


def hybrid_mixer(h, w_in, b_in, lam_re, lam_im, log_dt, b_re, b_im, c_re, c_im, d, w_glu, b_glu,
                 q_norm, w_q_up, kv_norm, w_kv_up, sgu_g, sgu_b, w_s, b_s, w_branch, w_out, cos, sin):
    bsz, seq, _ = h.shape
    proj = h @ w_in + b_in
    u_s5, cq, ckv, k_pe, u_sgu, v_sgu, gate_logits = jnp.split(proj, IN_OFFSETS, axis=-1)
    y_s5 = s5_mixer(u_s5, lam_re, lam_im, log_dt, b_re, b_im, c_re, c_im, d, w_glu, b_glu)
    y_mla = mla_mixer(cq, ckv, k_pe, q_norm, w_q_up, kv_norm, w_kv_up, cos, sin)
    y_sgu = sgu_mixer(u_sgu, v_sgu, sgu_g, sgu_b, w_s, b_s)
    gates = jax.nn.sigmoid(gate_logits).reshape(bsz, seq, N_BRANCH, D_MODEL)
    merged = (gates[:, :, 0] * (y_s5 @ w_branch[0])
              + gates[:, :, 1] * (y_mla @ w_branch[1])
              + gates[:, :, 2] * (y_sgu @ w_branch[2]))
    return merged @ w_out


def swiglu(h, w_in, w_out):
    a, b = jnp.split(h @ w_in, 2, axis=-1)
    return (jax.nn.silu(a) * b) @ w_out


def setup_inputs(seed: int = 0) -> dict:
    key = jax.random.key(seed)
    ks = jax.random.split(key, 32)
    L = DEPTH

    def nrm(k, shape, std):
        return jax.random.normal(k, shape, jnp.float32) * std

    def gain(k, shape):
        return 1.0 + nrm(k, shape, 0.01)

    lam_im0 = jnp.broadcast_to(math.pi * jnp.arange(S5_STATE, dtype=jnp.float32), (L, S5_GROUPS, S5_STATE))
    return {
        'x': nrm(ks[0], (BATCH, SEQ, D_MODEL), 1.0),
        'c': nrm(ks[1], (BATCH, D_MODEL), 1.0),
        'w_ada': nrm(ks[2], (L, D_MODEL, 6 * D_MODEL), 0.02),
        'b_ada': nrm(ks[3], (L, 6 * D_MODEL), 0.01),
        'w_in': nrm(ks[4], (L, D_MODEL, IN_WIDTH), D_MODEL ** -0.5),
        'b_in': nrm(ks[5], (L, IN_WIDTH), 0.01),
        's5_lambda_re': -0.5 + nrm(ks[6], (L, S5_GROUPS, S5_STATE), 0.01),
        's5_lambda_im': lam_im0 + nrm(ks[7], (L, S5_GROUPS, S5_STATE), 0.01),
        's5_log_dt': jax.random.uniform(ks[8], (L, S5_GROUPS), jnp.float32, math.log(DT_MIN), math.log(DT_MAX)),
        's5_b_re': nrm(ks[9], (L, S5_GROUPS, S5_STATE, S5_GROUP), (2 * S5_GROUP) ** -0.5),
        's5_b_im': nrm(ks[10], (L, S5_GROUPS, S5_STATE, S5_GROUP), (2 * S5_GROUP) ** -0.5),
        's5_c_re': nrm(ks[11], (L, S5_GROUPS, S5_GROUP, S5_STATE), S5_STATE ** -0.5),
        's5_c_im': nrm(ks[12], (L, S5_GROUPS, S5_GROUP, S5_STATE), S5_STATE ** -0.5),
        's5_d': nrm(ks[13], (L, S5_WIDTH), 1.0),
        's5_w_glu': nrm(ks[14], (L, S5_WIDTH, S5_WIDTH), S5_WIDTH ** -0.5),
        's5_b_glu': nrm(ks[15], (L, S5_WIDTH), 0.01),
        'mla_q_norm': gain(ks[16], (L, Q_LORA)),
        'mla_w_q_up': nrm(ks[17], (L, Q_LORA, MLA_HEADS * (QK_NOPE + QK_ROPE)), Q_LORA ** -0.5),
        'mla_kv_norm': gain(ks[18], (L, KV_LORA)),
        'mla_w_kv_up': nrm(ks[19], (L, KV_LORA, MLA_HEADS * (QK_NOPE + V_HEAD)), KV_LORA ** -0.5),
        'sgu_ln_g': gain(ks[20], (L, SGU_WIDTH)),
        'sgu_ln_b': nrm(ks[21], (L, SGU_WIDTH), 0.01),
        'sgu_w_s': nrm(ks[22], (L, SGU_GROUPS, SGU_CHUNK, SGU_CHUNK), SGU_CHUNK ** -0.5),
        'sgu_b_s': gain(ks[23], (L, SGU_GROUPS, SGU_CHUNK)),
        'w_branch': nrm(ks[24], (L, N_BRANCH, BRANCH_WIDTH, D_MODEL), BRANCH_WIDTH ** -0.5),
        'w_out': nrm(ks[25], (L, D_MODEL, D_MODEL), DEEPNORM_BETA * D_MODEL ** -0.5),
        'ln1_g': gain(ks[26], (L, D_MODEL)),
        'ln1_b': nrm(ks[27], (L, D_MODEL), 0.01),
        'ffn_w_in': nrm(ks[28], (L, D_MODEL, 2 * FF_HIDDEN), D_MODEL ** -0.5),
        'ffn_w_out': nrm(ks[29], (L, FF_HIDDEN, D_MODEL), DEEPNORM_BETA * FF_HIDDEN ** -0.5),
        'ln2_g': gain(ks[30], (L, D_MODEL)),
        'ln2_b': nrm(ks[31], (L, D_MODEL), 0.01),
    }


def reference(x, c, w_ada, b_ada, w_in, b_in, s5_lambda_re, s5_lambda_im, s5_log_dt, s5_b_re, s5_b_im,
              s5_c_re, s5_c_im, s5_d, s5_w_glu, s5_b_glu, mla_q_norm, mla_w_q_up, mla_kv_norm, mla_w_kv_up,
              sgu_ln_g, sgu_ln_b, sgu_w_s, sgu_b_s, w_branch, w_out, ln1_g, ln1_b, ffn_w_in, ffn_w_out,
              ln2_g, ln2_b):
    seq = x.shape[1]
    inv_freq = 1.0 / (ROPE_THETA ** (jnp.arange(0, QK_ROPE, 2, dtype=jnp.float32) / QK_ROPE))
    ang = jnp.arange(seq, dtype=jnp.float32)[:, None] * inv_freq[None, :]
    cos = jnp.cos(ang).astype(x.dtype)
    sin = jnp.sin(ang).astype(x.dtype)
    c_act = jax.nn.silu(c)
    for l in range(DEPTH):
        ada = (c_act @ w_ada[l] + b_ada[l])[:, None, :]
        sh1, sc1, g1, sh2, sc2, g2 = jnp.split(ada, 6, axis=-1)
        h = x * (1.0 + sc1) + sh1
        y = hybrid_mixer(h, w_in[l], b_in[l], s5_lambda_re[l], s5_lambda_im[l], s5_log_dt[l],
                         s5_b_re[l], s5_b_im[l], s5_c_re[l], s5_c_im[l], s5_d[l], s5_w_glu[l], s5_b_glu[l],
                         mla_q_norm[l], mla_w_q_up[l], mla_kv_norm[l], mla_w_kv_up[l],
                         sgu_ln_g[l], sgu_ln_b[l], sgu_w_s[l], sgu_b_s[l], w_branch[l], w_out[l], cos, sin)
        x = layer_norm(DEEPNORM_ALPHA * x + (1.0 + g1) * y, ln1_g[l], ln1_b[l])
        h = x * (1.0 + sc2) + sh2
        f = swiglu(h, ffn_w_in[l], ffn_w_out[l])
        x = layer_norm(DEEPNORM_ALPHA * x + (1.0 + g2) * f, ln2_g[l], ln2_b[l])
    return x
```

```cpp
#include <hip/hip_runtime.h>
#include <hip/hip_cooperative_groups.h>
#include <cstdint>
#include <cstdio>
namespace cg = cooperative_groups;

#define LAS __attribute__((address_space(3)))
typedef unsigned short bf16_t;
typedef short bf16x8 __attribute__((ext_vector_type(8)));
typedef float f32x4 __attribute__((ext_vector_type(4)));
typedef float f32x16 __attribute__((ext_vector_type(16)));
typedef unsigned u32x4 __attribute__((ext_vector_type(4)));
typedef unsigned u32x2 __attribute__((ext_vector_type(2)));

constexpr int SEQ = 4096, MTOK = 16384, DM = 1024, DEPTH = 4;
constexpr int INW = 5280, INP = 5376;
constexpr int O_US5 = 0, O_CQ = 512, O_CKV = 896, O_KPE = 1152, O_USGU = 1184, O_VSGU = 1696, O_GATE = 2208;
constexpr int FF = 2816, FF2 = 5632, QW = 768;
constexpr float ALPHA = 1.681792830507429f;
constexpr float QSCALE = 0.14724444602590306f;
constexpr int LDS_BYTES = 135168;

constexpr size_t al256(size_t x) { return (x + 255) & ~(size_t)255; }
constexpr size_t WS_W_IN = 0;
constexpr size_t WS_W_Q = WS_W_IN + (size_t)INP * 1024 * 2;
constexpr size_t WS_W_KV = WS_W_Q + (size_t)768 * 384 * 2;
constexpr size_t WS_W_GLU = WS_W_KV + (size_t)1024 * 256 * 2;
constexpr size_t WS_W_BR = WS_W_GLU + (size_t)512 * 512 * 2;
constexpr size_t WS_W_OUT = WS_W_BR + (size_t)3 * 1024 * 512 * 2;
constexpr size_t WS_W_F1 = WS_W_OUT + (size_t)1024 * 1024 * 2;
constexpr size_t WS_W_F2 = WS_W_F1 + (size_t)FF2 * 1024 * 2;
constexpr size_t WS_B_INP = WS_W_F2 + (size_t)1024 * FF * 2;
constexpr size_t WS_SGUW = WS_B_INP + (size_t)INP * 4;
constexpr size_t WS_S5BB = WS_SGUW + (size_t)4 * 128 * 128 * 2;
constexpr size_t WS_S5CM = WS_S5BB + (size_t)32 * 128 * 16 * 2;
constexpr size_t WS_S5A = WS_S5CM + (size_t)32 * 16 * 128 * 2;
constexpr size_t WS_S5A64 = WS_S5A + (size_t)32 * 64 * 2 * 4;
constexpr size_t WS_ADA = al256(WS_S5A64 + (size_t)32 * 64 * 2 * 4);
constexpr size_t WS_COS = WS_ADA + (size_t)4 * 4 * 6144 * 4;
constexpr size_t WS_SIN = WS_COS + (size_t)4096 * 16 * 4;
constexpr size_t WS_STAT = WS_SIN + (size_t)4096 * 16 * 4;
constexpr size_t WS_EBUF = WS_STAT + (size_t)4 * 16384 * 4;
constexpr size_t WS_PROJ = al256(WS_EBUF + (size_t)256 * 32 * 128 * 4);
constexpr size_t WS_XCUR = WS_PROJ + (size_t)MTOK * INP * 2;
constexpr size_t WS_PRE = WS_XCUR + (size_t)MTOK * DM * 4;
constexpr size_t WS_KF = WS_PRE;
constexpr size_t WS_VT = WS_KF + (size_t)MTOK * QW * 2;
constexpr size_t WS_Z = WS_VT + (size_t)2048 * 4096 * 2;
constexpr size_t WS_HB = WS_PRE + (size_t)MTOK * DM * 4;
constexpr size_t WS_QB = WS_HB + (size_t)MTOK * DM * 2;
constexpr size_t WS_END = WS_QB + (size_t)MTOK * QW * 2;
static_assert(WS_Z + (size_t)MTOK * 512 * 2 <= WS_HB, "overlay");

__device__ __forceinline__ unsigned cvt_pk_bf16(float lo, float hi) { unsigned r; asm volatile("v_cvt_pk_bf16_f32 %0, %1, %2" : "=v"(r) : "v"(lo), "v"(hi)); return r; }
__device__ __forceinline__ bf16_t f2bf(float x) { return (bf16_t)(cvt_pk_bf16(x, 0.f) & 0xffffu); }
__device__ __forceinline__ float bf2f(bf16_t v) { return __uint_as_float((unsigned)v << 16); }
__device__ __forceinline__ float bflo(unsigned w) { return __uint_as_float(w << 16); }
__device__ __forceinline__ float bfhi(unsigned w) { return __uint_as_float(w & 0xffff0000u); }
__device__ __forceinline__ float fexp2(float x) { return __builtin_amdgcn_exp2f(x); }
__device__ __forceinline__ float frcp(float x) { return __builtin_amdgcn_rcpf(x); }
__device__ __forceinline__ float sigmoidf_(float x) { return frcp(1.0f + fexp2(-1.4426950408889634f * x)); }
__device__ __forceinline__ float siluf_(float x) { return x * sigmoidf_(x); }
__device__ __forceinline__ float geluf_(float x) { const float u = 1.5957691216057308f * (x + 0.044715f * x * x * x); return x * sigmoidf_(u); }
__device__ __forceinline__ float wave_sum(float v) {
#pragma unroll
    for (int o = 32; o > 0; o >>= 1) v += __shfl_xor(v, o);
    return v;
}
__device__ __forceinline__ void sincos_rr(float x, float& s, float& c) {
    const float k = rintf(x * 0.15915494309189535f);
    float r = fmaf(-k, 6.2831854820251465f, x);
    r = fmaf(-k, -1.7484555e-07f, r);
    s = sinf(r); c = cosf(r);
}
__device__ const float INV_FREQ[16] = {1.000000000e+00f, 5.623413324e-01f, 3.162277639e-01f, 1.778279394e-01f, 1.000000015e-01f, 5.623412877e-02f, 3.162277862e-02f, 1.778279431e-02f,
                                       9.999999776e-03f, 5.623413250e-03f, 3.162277862e-03f, 1.778279431e-03f, 1.000000047e-03f, 5.623413017e-04f, 3.162277862e-04f, 1.778279402e-04f};

namespace pg8 {
constexpr int BM = 256, BK = 64, HALF = 128, HTB = HALF * BK * 2, STAGE_BYTES = 8 * HTB, NXCD = 8, WGM = 8;
__device__ __forceinline__ int lds_byte(int r, int c) { const int st = (r >> 4) * 2 + (c >> 5), rr = r & 15, cc = c & 31, ob = rr * 64 + cc * 2; return st * 1024 + (ob ^ (((ob >> 9) & 1) << 5)); }
__device__ __forceinline__ void stage_rc(int b, int& R, int& C) { const int st = b / 1024, sb = b % 1024, swz = sb ^ (((sb >> 9) & 1) << 5); R = (st >> 1) * 16 + swz / 64; C = (st & 1) * 32 + (swz % 64) / 2; }
__device__ __forceinline__ int perm32(int rho) { const int n = rho >> 4, i = rho & 15; return 8 * (i >> 2) + 4 * n + (i & 3); }
struct Unit { int pm, pn; };
struct Gemm { const bf16_t* A; const bf16_t* Bt; int M, N, K, lda; };
struct StaticOrder {
    int nM, nN, nwg, G, c;
    __device__ void init(int M, int N, int G_, int c_) { nM = M / BM; nN = N / BM; nwg = nM * nN; G = G_; c = c_; }
    __device__ bool next(int i, Unit& u) const {
        const long L = (long)i * G + c; if (L >= nwg) return false;
        int wgid = (int)L; { const int q = nwg / NXCD, r = nwg % NXCD, xcd = wgid % NXCD, off = wgid / NXCD; wgid = (xcd < r ? xcd * (q + 1) : r * (q + 1) + (xcd - r) * q) + off; }
        const int nig = WGM * nN, gid = wgid / nig, fm = gid * WGM, gsz = (nM - fm) < WGM ? (nM - fm) : WGM;
        u.pm = fm + ((wgid % nig) % gsz); u.pn = (wgid % nig) / gsz; return true;
    }
};
template <class Epi>
__device__ __forceinline__ void gemm_phase(LAS unsigned char* lds, const Gemm g, const StaticOrder& S, const Epi& E) {
#if defined(NO_GEMM)
    return;
#endif
    int tid = threadIdx.x; asm volatile("" : "+v"(tid));
    const int wid = __builtin_amdgcn_readfirstlane(tid >> 6), lane = tid & 63, wr = wid >> 2, wc = wid & 3, fr = lane & 15, fq = lane >> 4;
    const int K = g.K, nt = K / BK, lda = g.lda;
    unsigned voffA[2], voffB[2];
#pragma unroll
    for (int i = 0; i < 2; ++i) { int R, C; stage_rc(tid * 16 + i * 8192, R, C); const int Rb = Epi::PERM ? ((R & ~31) + perm32(R & 31)) : R;
        voffA[i] = (unsigned)(R * lda + C) * 2u; voffB[i] = (unsigned)(Rb * K + C) * 2u; }
    const size_t kstep = (size_t)(BK * 2);
    const size_t hstepA = (size_t)HALF * lda * 2, hstepB = (size_t)HALF * K * 2;
    const size_t tstepA = 2 * hstepA, tstepB = 2 * hstepB;
    const unsigned ldsw = (unsigned)wid * 1024u;
    const int aoff = lds_byte(wr * 64 + fr, fq * 8), boff = lds_byte(wc * 32 + fr, fq * 8);
#define PG8_SA(b, h) (((b) * 2 + (h)) * HTB)
#define PG8_SB(b, h) ((4 + (b) * 2 + (h)) * HTB)
#define PG8_STAGE(bufoff, gbase, voff) do { _Pragma("unroll") for (int _i = 0; _i < 2; ++_i) \
        __builtin_amdgcn_global_load_lds((const unsigned*)((const char*)(gbase) + (voff)[_i]), (LAS unsigned*)(lds + (bufoff) + ldsw + _i * 8192), 16, 0, 0); } while (0)
#define PG8_LDA(dst, b, h) do { _Pragma("unroll") for (int m = 0; m < 4; ++m) _Pragma("unroll") for (int k = 0; k < 2; ++k) dst[m][k] = *(const LAS bf16x8*)(lds + PG8_SA(b, h) + aoff + m * 2048 + k * 1024); } while (0)
#define PG8_LDB(dst, b, h) do { _Pragma("unroll") for (int n = 0; n < 2; ++n) _Pragma("unroll") for (int k = 0; k < 2; ++k) dst[n][k] = *(const LAS bf16x8*)(lds + PG8_SB(b, h) + boff + n * 2048 + k * 1024); } while (0)
#define PG8_MMA(ai, bj, At, Bt) do { __builtin_amdgcn_s_setprio(1); _Pragma("unroll") for (int m = 0; m < 4; ++m) _Pragma("unroll") for (int n = 0; n < 2; ++n) _Pragma("unroll") for (int k = 0; k < 2; ++k) \
        acc[ai][bj][m][n] = __builtin_amdgcn_mfma_f32_16x16x32_bf16(Bt[n][k], At[m][k], acc[ai][bj][m][n], 0, 0, 0); __builtin_amdgcn_s_setprio(0); } while (0)
#define PG8_WAIT_V(n) asm volatile("s_waitcnt vmcnt(" #n ")" ::: "memory")
#define PG8_WAIT_L(n) asm volatile("s_waitcnt lgkmcnt(" #n ")" ::: "memory")
#define PG8_BAR __builtin_amdgcn_s_barrier()
#define PG8_SCHED __builtin_amdgcn_sched_barrier(0)
    Unit cur, nxt; int ui = 0;
    if (!S.next(0, cur)) return;
    f32x4 acc[2][2][4][2];
#pragma unroll
    for (int a = 0; a < 2; ++a)
#pragma unroll
        for (int b = 0; b < 2; ++b)
#pragma unroll
            for (int m = 0; m < 4; ++m)
#pragma unroll
                for (int n = 0; n < 2; ++n) acc[a][b][m][n] = (f32x4){0.f, 0.f, 0.f, 0.f};
    bf16x8 At[4][2], B0[2][2], B1[2][2];
    const char* cA = (const char*)g.A + (size_t)cur.pm * tstepA; const char* cB = (const char*)g.Bt + (size_t)cur.pn * tstepB;
    PG8_STAGE(PG8_SB(0, 0), cB, voffB); PG8_STAGE(PG8_SB(0, 1), cB + hstepB, voffB); PG8_STAGE(PG8_SA(0, 0), cA, voffA); PG8_STAGE(PG8_SA(0, 1), cA + hstepA, voffA);
    if (wr == 1) PG8_BAR;
    PG8_WAIT_V(2); PG8_BAR;
    PG8_STAGE(PG8_SB(1, 0), cB + kstep, voffB); PG8_STAGE(PG8_SA(1, 0), cA + kstep, voffA); PG8_STAGE(PG8_SB(1, 1), cB + hstepB + kstep, voffB);
    PG8_WAIT_V(6); PG8_BAR;
    for (;;) {
        const bool has_next = S.next(ui + 1, nxt);
        const char* nA = has_next ? (const char*)g.A + (size_t)nxt.pm * tstepA : cA; const char* nB = has_next ? (const char*)g.Bt + (size_t)nxt.pn * tstepB : cB;
#pragma unroll 1
        for (int t = 0; t < nt; t += 2) {
            const bool last = (t == nt - 2);
            const char* a1 = cA + (size_t)(t + 1) * kstep;
            const char* a2 = last ? nA : cA + (size_t)(t + 2) * kstep; const char* b2 = last ? nB : cB + (size_t)(t + 2) * kstep;
            const char* a3 = a2 + kstep; const char* b3 = b2 + kstep;
            PG8_LDB(B0, 0, 0); PG8_LDB(B1, 0, 1); PG8_SCHED; PG8_LDA(At, 0, 0); PG8_STAGE(PG8_SA(1, 1), a1 + hstepA, voffA);
            PG8_WAIT_V(8); PG8_WAIT_L(0); PG8_BAR; PG8_MMA(0, 0, At, B0); PG8_MMA(0, 1, At, B1); PG8_BAR; PG8_SCHED;
            PG8_LDA(At, 0, 1); PG8_STAGE(PG8_SB(0, 0), b2, voffB); PG8_STAGE(PG8_SB(0, 1), b2 + hstepB, voffB); PG8_STAGE(PG8_SA(0, 0), a2, voffA);
            PG8_WAIT_V(8); PG8_WAIT_L(0); PG8_BAR; PG8_MMA(1, 0, At, B0); PG8_MMA(1, 1, At, B1); PG8_BAR; PG8_SCHED;
            PG8_LDB(B0, 1, 0); PG8_LDB(B1, 1, 1); PG8_SCHED; PG8_LDA(At, 1, 0); PG8_STAGE(PG8_SA(0, 1), a2 + hstepA, voffA);
            PG8_WAIT_V(8); PG8_WAIT_L(0); PG8_BAR; PG8_MMA(0, 0, At, B0); PG8_MMA(0, 1, At, B1); PG8_BAR; PG8_SCHED;
            PG8_LDA(At, 1, 1); PG8_STAGE(PG8_SB(1, 0), b3, voffB); PG8_STAGE(PG8_SB(1, 1), b3 + hstepB, voffB); PG8_STAGE(PG8_SA(1, 0), a3, voffA);
            PG8_WAIT_V(8); PG8_WAIT_L(0); PG8_BAR; PG8_MMA(1, 0, At, B0); PG8_MMA(1, 1, At, B1); PG8_BAR; PG8_SCHED;
        }
        if (wr == 0) PG8_BAR;
        E(acc, cur, wr, wc, fr, fq);
        if (!has_next) break;
#pragma unroll
        for (int a = 0; a < 2; ++a)
#pragma unroll
            for (int b = 0; b < 2; ++b)
#pragma unroll
                for (int m = 0; m < 4; ++m)
#pragma unroll
                    for (int n = 0; n < 2; ++n) acc[a][b][m][n] = (f32x4){0.f, 0.f, 0.f, 0.f};
        cur = nxt; cA = nA; cB = nB; ++ui;
        if (wr == 1) PG8_BAR;
    }
    PG8_WAIT_V(0);
    PG8_BAR;
#undef PG8_SA
#undef PG8_SB
#undef PG8_STAGE
#undef PG8_LDA
#undef PG8_LDB
#undef PG8_MMA
#undef PG8_WAIT_V
#undef PG8_WAIT_L
#undef PG8_BAR
#undef PG8_SCHED
}
}
using pg8::Unit;
typedef f32x4 AccT[2][2][4][2];

__device__ __forceinline__ u32x4 pack8(const f32x4 a, const f32x4 b) { u32x4 w; w.x = cvt_pk_bf16(a[0], a[1]); w.y = cvt_pk_bf16(a[2], a[3]); w.z = cvt_pk_bf16(b[0], b[1]); w.w = cvt_pk_bf16(b[2], b[3]); return w; }
__device__ __forceinline__ void unpack8(const u32x4 w, f32x4& a, f32x4& b) { a = (f32x4){bflo(w.x), bfhi(w.x), bflo(w.y), bfhi(w.y)}; b = (f32x4){bflo(w.z), bfhi(w.z), bflo(w.w), bfhi(w.w)}; }

struct EpiProj { static constexpr bool PERM = true;
    bf16_t* O; const float* bias;
    __device__ __forceinline__ void operator()(const AccT& acc, const Unit& u, int wr, int wc, int fr, int fq) const {
        const int row0 = u.pm * 256 + wr * 64 + fr, col0 = u.pn * 256 + wc * 32 + 8 * fq;
#pragma unroll
        for (int bj = 0; bj < 2; ++bj) { const f32x4 b0 = *(const f32x4*)(bias + col0 + bj * 128), b1 = *(const f32x4*)(bias + col0 + bj * 128 + 4);
#pragma unroll
            for (int ai = 0; ai < 2; ++ai)
#pragma unroll
                for (int m = 0; m < 4; ++m) { bf16_t* p = O + (size_t)(row0 + ai * 128 + m * 16) * INP + col0 + bj * 128;
                    *(u32x4*)p = pack8(acc[ai][bj][m][0] + b0, acc[ai][bj][m][1] + b1); } }
    }
};
struct EpiQ { static constexpr bool PERM = true;
    bf16_t* Q; const float* rstd;
    __device__ __forceinline__ void operator()(const AccT& acc, const Unit& u, int wr, int wc, int fr, int fq) const {
        const int row0 = u.pm * 256 + wr * 64 + fr, col0 = u.pn * 256 + wc * 32 + 8 * fq;
#pragma unroll
        for (int ai = 0; ai < 2; ++ai)
#pragma unroll
            for (int m = 0; m < 4; ++m) { const int row = row0 + ai * 128 + m * 16; const float sc = rstd[row] * QSCALE;
#pragma unroll
                for (int bj = 0; bj < 2; ++bj) *(u32x4*)(Q + (size_t)row * QW + col0 + bj * 128) = pack8(acc[ai][bj][m][0] * sc, acc[ai][bj][m][1] * sc); }
    }
};
struct EpiKV { static constexpr bool PERM = true;
    bf16_t* Kf; bf16_t* Vn; const float* rstd;
    __device__ __forceinline__ void operator()(const AccT& acc, const Unit& u, int wr, int wc, int fr, int fq) const {
        const int row0 = u.pm * 256 + wr * 64 + fr;
#pragma unroll
        for (int ai = 0; ai < 2; ++ai)
#pragma unroll
            for (int m = 0; m < 4; ++m) { const int row = row0 + ai * 128 + m * 16; const float sc = rstd[row];
#pragma unroll
                for (int bj = 0; bj < 2; ++bj) { const int n0 = u.pn * 256 + bj * 128 + wc * 32 + 8 * fq; const u32x4 w = pack8(acc[ai][bj][m][0] * sc, acc[ai][bj][m][1] * sc);
                    if (u.pn < 2) *(u32x4*)(Kf + (size_t)row * QW + (n0 >> 6) * 96 + (n0 & 63)) = w;
                    else *(u32x4*)(Vn + (size_t)row * 512 + (n0 - 512)) = w; } }
    }
};
struct EpiGlu { static constexpr bool PERM = true;
    const bf16_t* Z; bf16_t* O; const float* bias;
    __device__ __forceinline__ void operator()(const AccT& acc, const Unit& u, int wr, int wc, int fr, int fq) const {
        const int row0 = u.pm * 256 + wr * 64 + fr, col0 = u.pn * 256 + wc * 32 + 8 * fq;
#pragma unroll
        for (int bj = 0; bj < 2; ++bj) { const int col = col0 + bj * 128; const f32x4 b0 = *(const f32x4*)(bias + col), b1 = *(const f32x4*)(bias + col + 4);
#pragma unroll
            for (int ai = 0; ai < 2; ++ai)
#pragma unroll
                for (int m = 0; m < 4; ++m) { const int row = row0 + ai * 128 + m * 16; f32x4 z0, z1; unpack8(*(const u32x4*)(Z + (size_t)row * 512 + col), z0, z1);
                    f32x4 a0 = acc[ai][bj][m][0] + b0, a1 = acc[ai][bj][m][1] + b1;
#pragma unroll
                    for (int j = 0; j < 4; ++j) { a0[j] = z0[j] * sigmoidf_(a0[j]); a1[j] = z1[j] * sigmoidf_(a1[j]); }
                    *(u32x4*)(O + (size_t)row * INP + O_US5 + col) = pack8(a0, a1); asm volatile("" ::: "memory"); } }
    }
};
template <int MODE> struct EpiBranch { static constexpr bool PERM = true;
    const bf16_t* gate; float* macc; bf16_t* merged;
    __device__ __forceinline__ void operator()(const AccT& acc, const Unit& u, int wr, int wc, int fr, int fq) const {
        const int row0 = u.pm * 256 + wr * 64 + fr, col0 = u.pn * 256 + wc * 32 + 8 * fq;
#pragma unroll
        for (int ai = 0; ai < 2; ++ai)
#pragma unroll
            for (int m = 0; m < 4; ++m) { const int row = row0 + ai * 128 + m * 16;
#pragma unroll
                for (int bj = 0; bj < 2; ++bj) { const int col = col0 + bj * 128; f32x4 g0, g1; unpack8(*(const u32x4*)(gate + (size_t)row * INP + col), g0, g1);
                    f32x4 a0 = acc[ai][bj][m][0], a1 = acc[ai][bj][m][1];
#pragma unroll
                    for (int j = 0; j < 4; ++j) { a0[j] *= sigmoidf_(g0[j]); a1[j] *= sigmoidf_(g1[j]); }
                    float* mp = macc + (size_t)row * DM + col;
                    if (MODE >= 1) { a0 += *(const f32x4*)mp; a1 += *(const f32x4*)(mp + 4); }
                    if (MODE <= 1) { *(f32x4*)mp = a0; *(f32x4*)(mp + 4) = a1; }
                    else *(u32x4*)(merged + (size_t)row * DM + col) = pack8(a0, a1); asm volatile("" ::: "memory"); } }
    }
};
struct EpiRes { static constexpr bool PERM = false;
    const float* xres; float* pre; const float* gate;
    __device__ __forceinline__ void operator()(const AccT& acc, const Unit& u, int wr, int wc, int fr, int fq) const {
        const int row0 = u.pm * 256 + wr * 64 + fr, col0 = u.pn * 256 + wc * 32 + 4 * fq; const int b = (u.pm * 256) >> 12;
#pragma unroll
        for (int bj = 0; bj < 2; ++bj)
#pragma unroll
            for (int n = 0; n < 2; ++n) { const int col = col0 + bj * 128 + n * 16; const f32x4 gv = *(const f32x4*)(gate + b * 6144 + col) + 1.0f;
#pragma unroll
                for (int ai = 0; ai < 2; ++ai)
#pragma unroll
                    for (int m = 0; m < 4; ++m) { const size_t off = (size_t)(row0 + ai * 128 + m * 16) * DM + col;
                        const f32x4 xv = *(const f32x4*)(xres + off); *(f32x4*)(pre + off) = xv * ALPHA + gv * acc[ai][bj][m][n]; if (m & 1) asm volatile("" ::: "memory"); } }
    }
};
struct EpiFfn1 { static constexpr bool PERM = true;
    bf16_t* H;
    __device__ __forceinline__ void operator()(const AccT& acc, const Unit& u, int wr, int wc, int fr, int fq) const {
        const int row0 = u.pm * 256 + wr * 64 + fr, hc0 = u.pn * 128 + wc * 16 + 4 * fq;
#pragma unroll
        for (int ai = 0; ai < 2; ++ai)
#pragma unroll
            for (int m = 0; m < 4; ++m) { const int row = row0 + ai * 128 + m * 16;
#pragma unroll
                for (int bj = 0; bj < 2; ++bj) { const f32x4 a = acc[ai][bj][m][0], bb = acc[ai][bj][m][1]; u32x2 w;
                    w.x = cvt_pk_bf16(siluf_(a[0]) * bb[0], siluf_(a[1]) * bb[1]); w.y = cvt_pk_bf16(siluf_(a[2]) * bb[2], siluf_(a[3]) * bb[3]);
                    *(u32x2*)(H + (size_t)row * FF + hc0 + bj * 64) = w; } }
    }
};

struct Params {
    const float* in[32];
    float* out;
    unsigned char* ws;
};
typedef const __attribute__((address_space(4))) unsigned char* kaptr_t;
typedef const __attribute__((address_space(4))) unsigned long long* kau64_t;
struct Ctx {
    kaptr_t ka;
    __device__ __forceinline__ const float* in(int k) const { return (const float*)(*(kau64_t)(ka + 8 * k)); }
    __device__ __forceinline__ float* out() const { return (float*)(*(kau64_t)(ka + 256)); }
    __device__ __forceinline__ unsigned char* wsb() const { return (unsigned char*)(*(kau64_t)(ka + 264)); }
#define WSP_(T, name, off) __device__ __forceinline__ T* name() const { return (T*)(wsb() + (off)); }
    WSP_(bf16_t, w_in, WS_W_IN) WSP_(bf16_t, w_q, WS_W_Q) WSP_(bf16_t, w_kv, WS_W_KV) WSP_(bf16_t, w_glu, WS_W_GLU) WSP_(bf16_t, w_br, WS_W_BR) WSP_(bf16_t, w_out, WS_W_OUT)
    WSP_(bf16_t, w_f1, WS_W_F1) WSP_(bf16_t, w_f2, WS_W_F2) WSP_(bf16_t, sguw, WS_SGUW) WSP_(bf16_t, s5bb, WS_S5BB) WSP_(bf16_t, s5cm, WS_S5CM)
    WSP_(float, b_inp, WS_B_INP) WSP_(float, s5a, WS_S5A) WSP_(float, s5a64, WS_S5A64) WSP_(float, ada, WS_ADA) WSP_(float, cosT, WS_COS) WSP_(float, sinT, WS_SIN)
    WSP_(float, rstd_q, WS_STAT) WSP_(float, rstd_kv, WS_STAT + 65536) WSP_(float, sgu_mean, WS_STAT + 131072) WSP_(float, sgu_rstd, WS_STAT + 196608) WSP_(float, ebuf, WS_EBUF)
    WSP_(float, xcur, WS_XCUR) WSP_(float, pre, WS_PRE) WSP_(bf16_t, proj, WS_PROJ) WSP_(bf16_t, hid, WS_PROJ) WSP_(bf16_t, kf, WS_KF) WSP_(bf16_t, vt, WS_VT) WSP_(bf16_t, zb, WS_Z)
    WSP_(bf16_t, hb, WS_HB) WSP_(bf16_t, merged, WS_HB) WSP_(bf16_t, qb, WS_QB)
#undef WSP_
};
__device__ __forceinline__ Ctx mk_ctx() { kaptr_t ka = (kaptr_t)__builtin_amdgcn_kernarg_segment_ptr(); asm volatile("" : "+s"(ka)); return Ctx{ka}; }
#define NEWCTX const Ctx C = mk_ctx()

template <int PERMT> __device__ __forceinline__ int perm_src(int n) {
    if (PERMT == 1) { return n < 512 ? (n >> 6) * 96 + (n & 63) : ((n - 512) >> 5) * 96 + 64 + ((n - 512) & 31); }
    if (PERMT == 2) { return n < 512 ? (n >> 6) * 128 + (n & 63) : ((n - 512) >> 6) * 128 + 64 + ((n - 512) & 63); }
    if (PERMT == 3) { const int q = n >> 3, r = n & 7; return r < 4 ? q * 4 + r : FF + q * 4 + (r - 4); }
    return n;
}
template <int PERMT> __device__ __forceinline__ void cvt_weight(const float* src, bf16_t* dst, const float* scale, int K, int Nsrc, int Nout, LAS unsigned char* lds) {
    LAS float* T = (LAS float*)lds;
    int tid = threadIdx.x; asm volatile("" : "+v"(tid));
    const int tk = K >> 6, tn = Nout >> 6, ntile = tk * tn;
#pragma unroll 1
    for (int t = blockIdx.x; t < ntile; t += gridDim.x) {
        const int k0 = (t % tk) * 64, n0 = (t / tk) * 64;
#pragma unroll
        for (int i = 0; i < 8; ++i) { const int kk = i * 8 + (tid >> 6), nn = tid & 63; const int sc = perm_src<PERMT>(n0 + nn);
            float v = (sc < Nsrc) ? src[(size_t)(k0 + kk) * Nsrc + sc] : 0.f; if (scale) v *= scale[k0 + kk]; T[kk * 65 + nn] = v; }
        __syncthreads();
#pragma unroll
        for (int i = 0; i < 4; ++i) { const int nn = i * 16 + (tid >> 5), kk = (tid & 31) * 2;
            *(unsigned*)(dst + (size_t)(n0 + nn) * K + k0 + kk) = cvt_pk_bf16(T[kk * 65 + nn], T[(kk + 1) * 65 + nn]); }
        __syncthreads();
    }
}
__device__ __forceinline__ void convert_layer(const Ctx& C, int l, LAS unsigned char* lds) {
    cvt_weight<0>(C.in(4) + (size_t)l * 1024 * INW, C.w_in(), nullptr, 1024, INW, INP, lds);
    cvt_weight<1>(C.in(17) + (size_t)l * 384 * 768, C.w_q(), C.in(16) + l * 384, 384, 768, 768, lds);
    cvt_weight<2>(C.in(19) + (size_t)l * 256 * 1024, C.w_kv(), C.in(18) + l * 256, 256, 1024, 1024, lds);
    cvt_weight<0>(C.in(14) + (size_t)l * 512 * 512, C.w_glu(), nullptr, 512, 512, 512, lds);
#pragma unroll 1
    for (int b = 0; b < 3; ++b) cvt_weight<0>(C.in(24) + ((size_t)l * 3 + b) * 512 * 1024, C.w_br() + (size_t)b * 1024 * 512, nullptr, 512, 1024, 1024, lds);
    cvt_weight<0>(C.in(25) + (size_t)l * 1024 * 1024, C.w_out(), nullptr, 1024, 1024, 1024, lds);
    cvt_weight<3>(C.in(28) + (size_t)l * 1024 * FF2, C.w_f1(), nullptr, 1024, FF2, FF2, lds);
    cvt_weight<0>(C.in(29) + (size_t)l * FF * 1024, C.w_f2(), nullptr, FF, 1024, 1024, lds);
    int tid2 = threadIdx.x; asm volatile("" : "+v"(tid2));
    const int gt = blockIdx.x * 512 + tid2, gs = gridDim.x * 512;
    for (int i = gt; i < INP; i += gs) C.b_inp()[i] = i < INW ? C.in(5)[(size_t)l * INW + i] : 0.f;
    for (int i = gt; i < 4 * 128 * 128; i += gs) { const int ii = (i >> 7) & 127, jj = i & 127; C.sguw()[i] = f2bf(((jj >> 6) <= (ii >> 6)) ? C.in(22)[(size_t)l * 65536 + i] : 0.f); }
#pragma unroll 1
    for (int i = gt; i < 2048; i += gs) {
        const int g = i >> 6, p = i & 63;
        const float dt = expf(C.in(8)[l * 32 + g]), lr = C.in(6)[l * 2048 + i], li = C.in(7)[l * 2048 + i];
        const float mag = expf(lr * dt); float sn, cs; sincos_rr(li * dt, sn, cs);
        const float are = mag * cs, aim = mag * sn, den = lr * lr + li * li;
        const float fre = ((are - 1.0f) * lr + aim * li) / den, fim = (aim * lr - (are - 1.0f) * li) / den;
        const float* br = C.in(9) + (size_t)l * 32768 + (size_t)i * 16; const float* bi = C.in(10) + (size_t)l * 32768 + (size_t)i * 16;
#pragma unroll
        for (int c = 0; c < 16; ++c) { const float r_ = br[c], i_ = bi[c];
            C.s5bb()[(size_t)(g * 128 + p) * 16 + c] = f2bf(fre * r_ - fim * i_); C.s5bb()[(size_t)(g * 128 + 64 + p) * 16 + c] = f2bf(fre * i_ + fim * r_); }
        C.s5a()[i * 2] = are; C.s5a()[i * 2 + 1] = aim;
        float pr = are, pi = aim;
#pragma unroll
        for (int s = 0; s < 6; ++s) { const float nr = pr * pr - pi * pi, ni = 2.0f * pr * pi; pr = nr; pi = ni; }
        C.s5a64()[i * 2] = pr; C.s5a64()[i * 2 + 1] = pi;
        const float* cr = C.in(11) + (size_t)l * 32768 + (size_t)g * 1024 + p; const float* ci = C.in(12) + (size_t)l * 32768 + (size_t)g * 1024 + p;
#pragma unroll
        for (int c = 0; c < 16; ++c) { C.s5cm()[(size_t)(g * 16 + c) * 128 + p] = f2bf(cr[c * 64]); C.s5cm()[(size_t)(g * 16 + c) * 128 + 64 + p] = f2bf(-ci[c * 64]); }
    }
}
__device__ __forceinline__ void ada_tables(const Ctx& C, LAS unsigned char* lds) {
    LAS float* cact = (LAS float*)lds;
    LAS float* red = (LAS float*)(lds + 16384);
    const int tid = threadIdx.x, lane = tid & 63, wid = tid >> 6;
    for (int i = tid; i < 4096; i += 512) cact[i] = siluf_(C.in(1)[i]);
    __syncthreads();
    for (int u = blockIdx.x; u < 4 * 96; u += gridDim.x) {
        const int l = u / 96, n = (u % 96) * 64 + lane;
        const float* w = C.in(2) + (size_t)l * 1024 * 6144 + n;
        float a0 = 0.f, a1 = 0.f, a2 = 0.f, a3 = 0.f;
        for (int k = wid * 128; k < wid * 128 + 128; ++k) { const float wv = w[(size_t)k * 6144]; a0 += cact[k] * wv; a1 += cact[1024 + k] * wv; a2 += cact[2048 + k] * wv; a3 += cact[3072 + k] * wv; }
        red[(wid * 4 + 0) * 64 + lane] = a0; red[(wid * 4 + 1) * 64 + lane] = a1; red[(wid * 4 + 2) * 64 + lane] = a2; red[(wid * 4 + 3) * 64 + lane] = a3;
        __syncthreads();
        if (tid < 256) { const int b = tid >> 6; float s = 0.f;
#pragma unroll
            for (int w8 = 0; w8 < 8; ++w8) s += red[(w8 * 4 + b) * 64 + lane];
            C.ada()[(size_t)(l * 4 + b) * 6144 + n] = s + C.in(3)[(size_t)l * 6144 + n]; }
        __syncthreads();
    }
    for (int i = blockIdx.x * 512 + tid; i < 4096 * 16; i += gridDim.x * 512) { const float ang = (float)(i >> 4) * INV_FREQ[i & 15]; float s, c; sincos_rr(ang, s, c); C.cosT()[i] = c; C.sinT()[i] = s; }
}
__device__ __forceinline__ void mod_x0(const Ctx& C) {
    const float* x = C.in(0);
    for (size_t i = (size_t)blockIdx.x * 512 + threadIdx.x; i < (size_t)MTOK * DM / 4; i += (size_t)gridDim.x * 512) {
        const size_t e = i * 4; const int row = (int)(e >> 10), col = (int)(e & 1023), b = row >> 12;
        const f32x4 xv = *(const f32x4*)(x + e), sh = *(const f32x4*)(C.ada() + b * 6144 + col), sc = *(const f32x4*)(C.ada() + b * 6144 + 1024 + col);
        const f32x4 h = xv * (sc + 1.0f) + sh; u32x2 w; w.x = cvt_pk_bf16(h[0], h[1]); w.y = cvt_pk_bf16(h[2], h[3]); *(u32x2*)(C.hb() + e) = w;
    }
}
__device__ __forceinline__ void ln_pass(const float* pre, const float* g, const float* bta, float* xout, bf16_t* hb, const float* sh, const float* sc) {
    const int lane = threadIdx.x & 63, wid = threadIdx.x >> 6;
    for (int row = blockIdx.x * 8 + wid; row < MTOK; row += gridDim.x * 8) {
        const float* p = pre + (size_t)row * DM; f32x4 v[4]; float s = 0.f;
#pragma unroll
        for (int i = 0; i < 4; ++i) { v[i] = *(const f32x4*)(p + i * 256 + lane * 4); s += (v[i][0] + v[i][1]) + (v[i][2] + v[i][3]); }
        const float mean = wave_sum(s) * (1.0f / 1024.0f); float q = 0.f;
#pragma unroll
        for (int i = 0; i < 4; ++i) { const f32x4 d = v[i] - mean; q += (d[0] * d[0] + d[1] * d[1]) + (d[2] * d[2] + d[3] * d[3]); }
        const float rstd = rsqrtf(wave_sum(q) * (1.0f / 1024.0f) + 1e-5f); const int b = row >> 12;
#pragma unroll
        for (int i = 0; i < 4; ++i) { const int col = i * 256 + lane * 4; const f32x4 xn = (v[i] - mean) * rstd * *(const f32x4*)(g + col) + *(const f32x4*)(bta + col);
            *(f32x4*)(xout + (size_t)row * DM + col) = xn;
            if (hb) { const f32x4 h = xn * (*(const f32x4*)(sc + b * 6144 + col) + 1.0f) + *(const f32x4*)(sh + b * 6144 + col); u32x2 w; w.x = cvt_pk_bf16(h[0], h[1]); w.y = cvt_pk_bf16(h[2], h[3]); *(u32x2*)(hb + (size_t)row * DM + col) = w; } }
    }
}
__device__ __forceinline__ void token_prepass(const Ctx& C) {
    const int lane = threadIdx.x & 63, wid = threadIdx.x >> 6;
    for (int row = blockIdx.x * 8 + wid; row < MTOK; row += gridDim.x * 8) {
        const bf16_t* pr = C.proj() + (size_t)row * INP;
        float ss = 0.f;
        if (lane < 48) { f32x4 a, b; unpack8(*(const u32x4*)(pr + O_CQ + lane * 8), a, b); ss = (a[0] * a[0] + a[1] * a[1]) + (a[2] * a[2] + a[3] * a[3]) + (b[0] * b[0] + b[1] * b[1]) + (b[2] * b[2] + b[3] * b[3]); }
        const float rq = rsqrtf(wave_sum(ss) * (1.0f / 384.0f) + 1e-6f);
        ss = 0.f;
        if (lane < 32) { f32x4 a, b; unpack8(*(const u32x4*)(pr + O_CKV + lane * 8), a, b); ss = (a[0] * a[0] + a[1] * a[1]) + (a[2] * a[2] + a[3] * a[3]) + (b[0] * b[0] + b[1] * b[1]) + (b[2] * b[2] + b[3] * b[3]); }
        const float rkv = rsqrtf(wave_sum(ss) * (1.0f / 256.0f) + 1e-6f);
        f32x4 a, b; unpack8(*(const u32x4*)(pr + O_VSGU + lane * 8), a, b);
#pragma unroll
        for (int j = 0; j < 4; ++j) { a[j] = geluf_(a[j]); b[j] = geluf_(b[j]); }
        const float mean = wave_sum((a[0] + a[1]) + (a[2] + a[3]) + (b[0] + b[1]) + (b[2] + b[3])) * (1.0f / 512.0f);
        a = a - mean; b = b - mean;
        const float var = wave_sum((a[0] * a[0] + a[1] * a[1]) + (a[2] * a[2] + a[3] * a[3]) + (b[0] * b[0] + b[1] * b[1]) + (b[2] * b[2] + b[3] * b[3])) * (1.0f / 512.0f);
        if (lane == 0) { C.rstd_q()[row] = rq; C.rstd_kv()[row] = rkv; C.sgu_mean()[row] = mean; C.sgu_rstd()[row] = rsqrtf(var + 1e-5f); }
        if (lane < 16) { const float x1 = bf2f(pr[O_KPE + lane]), x2 = bf2f(pr[O_KPE + 16 + lane]); const int pos = row & (SEQ - 1); const float cs = C.cosT()[pos * 16 + lane], sn = C.sinT()[pos * 16 + lane];
            const bf16_t o1 = f2bf(x1 * cs - x2 * sn), o2 = f2bf(x2 * cs + x1 * sn); bf16_t* kp = C.kf() + (size_t)row * QW + 64 + lane;
#pragma unroll
            for (int h = 0; h < 8; ++h) { kp[h * 96] = o1; kp[h * 96 + 16] = o2; } }
    }
}
__device__ __forceinline__ void sgu_phase(const Ctx& C, int l, LAS unsigned char* lds) {
    int tid = threadIdx.x; asm volatile("" : "+v"(tid));
    const int lane = tid & 63, wid = tid >> 6, fr = lane & 15, fq = lane >> 4;
    const float* ln_g = C.in(20) + l * 512; const float* ln_b = C.in(21) + l * 512; const float* b_s = C.in(23) + l * 512;
    for (int u = blockIdx.x; u < 512; u += gridDim.x) {
        const int n = u >> 2, g = u & 3, r0 = n * 128, c0 = g * 128;
#pragma unroll
        for (int i = 0; i < 4; ++i) { const int p = tid + 512 * i, j = p & 127, cp = p >> 7; const size_t row = r0 + j;
            f32x4 a, b; unpack8(*(const u32x4*)(C.proj() + row * INP + O_VSGU + c0 + cp * 8), a, b);
            const float mean = C.sgu_mean()[row], rstd = C.sgu_rstd()[row]; const f32x4 g0 = *(const f32x4*)(ln_g + c0 + cp * 8), g1 = *(const f32x4*)(ln_g + c0 + cp * 8 + 4), b0 = *(const f32x4*)(ln_b + c0 + cp * 8), b1 = *(const f32x4*)(ln_b + c0 + cp * 8 + 4);
#pragma unroll
            for (int e = 0; e < 4; ++e) { *(LAS bf16_t*)(lds + (cp * 8 + e) * 272 + j * 2) = f2bf((geluf_(a[e]) - mean) * rstd * g0[e] + b0[e]);
                                          *(LAS bf16_t*)(lds + (cp * 8 + 4 + e) * 272 + j * 2) = f2bf((geluf_(b[e]) - mean) * rstd * g1[e] + b1[e]); } }
        __syncthreads();
        bf16x8 af[4];
#pragma unroll
        for (int ks = 0; ks < 4; ++ks) af[ks] = *(const bf16x8*)(C.sguw() + (size_t)(g * 128 + 16 * wid + fr) * 128 + ks * 32 + fq * 8);
#pragma unroll
        for (int nt = 0; nt < 8; ++nt) { f32x4 acc = {0.f, 0.f, 0.f, 0.f};
#pragma unroll
            for (int ks = 0; ks < 4; ++ks) { const bf16x8 bfr = *(const LAS bf16x8*)(lds + (nt * 16 + fr) * 272 + (ks * 32 + fq * 8) * 2); acc = __builtin_amdgcn_mfma_f32_16x16x32_bf16(af[ks], bfr, acc, 0, 0, 0); }
#pragma unroll
            for (int r = 0; r < 4; ++r) { const int i = 16 * wid + 4 * fq + r; bf16_t* pu = C.proj() + (size_t)(r0 + i) * INP + O_USGU + c0 + nt * 16 + fr;
                *pu = f2bf(geluf_(bf2f(*pu)) * (acc[r] + b_s[g * 128 + i])); } }
        __syncthreads();
    }
}
template <bool FINAL> __device__ __forceinline__ void s5_phase(const Ctx& C, int l, LAS unsigned char* lds) {
    int tid = threadIdx.x; asm volatile("" : "+v"(tid));
    const int lane = tid & 63, wid = __builtin_amdgcn_readfirstlane(tid >> 6), r32 = lane & 31, hi = lane >> 5, fr = lane & 15, fq = lane >> 4;
    LAS unsigned char* wl = lds + wid * 16896;
    const float* dvec = C.in(13) + l * 512;
    for (int wu = blockIdx.x * 8 + wid; wu < 8192; wu += gridDim.x * 8) {
        const int m = wu >> 5, g = wu & 31, p = lane;
        const float are = C.s5a()[(g * 64 + p) * 2], aim = C.s5a()[(g * 64 + p) * 2 + 1];
        float hre = 0.f, him = 0.f;
        if (FINAL) { const int k = m & 63, mb = m - k; const float a64r = C.s5a64()[(g * 64 + p) * 2], a64i = C.s5a64()[(g * 64 + p) * 2 + 1];
            for (int j = 0; j < k; ++j) { const float* e = C.ebuf() + ((size_t)(mb + j) * 32 + g) * 128 + p; const float er = e[0], ei = e[64];
                const float nr = a64r * hre - a64i * him + er, ni = a64r * him + a64i * hre + ei; hre = nr; him = ni; } }
        bf16x8 bfr[4];
#pragma unroll
        for (int pt = 0; pt < 4; ++pt) bfr[pt] = *(const bf16x8*)(C.s5bb() + (size_t)(g * 128 + pt * 32 + r32) * 16 + hi * 8);
        for (int half = 0; half < 2; ++half) {
            const int t0 = m * 64 + half * 32;
            const bf16x8 afr = *(const bf16x8*)(C.proj() + (size_t)(t0 + r32) * INP + O_US5 + g * 16 + hi * 8);
#pragma unroll
            for (int pt = 0; pt < 4; ++pt) { f32x16 d = {}; d = __builtin_amdgcn_mfma_f32_32x32x16_bf16(afr, bfr[pt], d, 0, 0, 0);
#pragma unroll
                for (int r = 0; r < 16; ++r) { const int t = 8 * (r >> 2) + 4 * hi + (r & 3); *(LAS float*)(wl + t * 528 + (pt * 32 + r32) * 4) = d[r]; } }
            asm volatile("s_waitcnt lgkmcnt(0)" ::: "memory");
#pragma unroll
            for (int t = 0; t < 32; ++t) { const float br = *(const LAS float*)(wl + t * 528 + p * 4), bi = *(const LAS float*)(wl + t * 528 + 256 + p * 4);
                const float nr = are * hre - aim * him + br, ni = are * him + aim * hre + bi; hre = nr; him = ni;
                if (FINAL) { *(LAS bf16_t*)(wl + t * 528 + p * 2) = f2bf(nr); *(LAS bf16_t*)(wl + t * 528 + 128 + p * 2) = f2bf(ni); } }
            if (FINAL) {
                asm volatile("s_waitcnt lgkmcnt(0)" ::: "memory");
#pragma unroll
                for (int tt = 0; tt < 2; ++tt) { f32x4 acc = {0.f, 0.f, 0.f, 0.f};
#pragma unroll
                    for (int ks = 0; ks < 4; ++ks) { const bf16x8 a = *(const LAS bf16x8*)(wl + (tt * 16 + fr) * 528 + (ks * 32 + fq * 8) * 2);
                        const bf16x8 b = *(const bf16x8*)(C.s5cm() + (size_t)(g * 16 + fr) * 128 + ks * 32 + fq * 8); acc = __builtin_amdgcn_mfma_f32_16x16x32_bf16(a, b, acc, 0, 0, 0); }
                    const int c = g * 16 + fr; const float dd = dvec[c];
#pragma unroll
                    for (int r = 0; r < 4; ++r) { const size_t tok = (size_t)(t0 + tt * 16 + 4 * fq + r); const float uu = bf2f(C.proj()[tok * INP + O_US5 + c]);
                        C.zb()[tok * 512 + c] = f2bf(geluf_(acc[r] + dd * uu)); } }
                asm volatile("s_waitcnt lgkmcnt(0)" ::: "memory");
            }
        }
        if (!FINAL) { float* e = C.ebuf() + ((size_t)m * 32 + g) * 128 + p; e[0] = hre; e[64] = him; }
    }
}
__device__ __forceinline__ void attn_unit(const Ctx& C, int b, int h, int qb, LAS unsigned char* lds) {
    int tid = threadIdx.x; asm volatile("" : "+v"(tid));
    const int lane = tid & 63, wid = __builtin_amdgcn_readfirstlane(tid >> 6), r32 = lane & 31, hi = lane >> 5;
    const int NT = 4 * qb + 4, cw = 4 * qb + (wid >> 1);
    const size_t qrow = (size_t)b * SEQ + 256 * qb + 32 * wid + r32;
    bf16x8 qf[6];
#pragma unroll
    for (int ds = 0; ds < 4; ++ds) qf[ds] = *(const bf16x8*)(C.qb() + qrow * QW + h * 64 + ds * 16 + hi * 8);
    {
      f32x4 a0, a1, b0, b1; unpack8(*(const u32x4*)(C.qb() + qrow * QW + 512 + h * 32 + hi * 8), a0, a1); unpack8(*(const u32x4*)(C.qb() + qrow * QW + 512 + h * 32 + 16 + hi * 8), b0, b1);
      const int pos = (int)(qrow & (SEQ - 1)); const float* cp = C.cosT() + pos * 16 + hi * 8; const float* sp = C.sinT() + pos * 16 + hi * 8;
      const f32x4 c0 = *(const f32x4*)cp, c1 = *(const f32x4*)(cp + 4), s0 = *(const f32x4*)sp, s1 = *(const f32x4*)(sp + 4);
      qf[4] = __builtin_bit_cast(bf16x8, pack8(a0 * c0 - b0 * s0, a1 * c1 - b1 * s1)); qf[5] = __builtin_bit_cast(bf16x8, pack8(b0 * c0 + a0 * s0, b1 * c1 + a1 * s1)); }
    f32x16 o0 = {}, o1 = {}; float mrun = -1e30f, lrun = 0.f;
    const bf16_t* kbase = C.kf() + (size_t)b * SEQ * QW + h * 96;
    const bf16_t* vbase = C.vt() + (size_t)b * SEQ * 512 + h * 64;
    const int kk0 = tid / 12, pc0 = tid % 12, p1 = 512 + tid, kk1 = p1 / 12, pc1 = p1 % 12; const bool has1 = tid < 256;
    u32x4 kr0, kr1 = {0u, 0u, 0u, 0u}, vr;
#define ATT_LOAD(t) do { kr0 = *(const u32x4*)(kbase + (size_t)((t) * 64 + kk0) * QW + pc0 * 8); if (has1) kr1 = *(const u32x4*)(kbase + (size_t)((t) * 64 + kk1) * QW + pc1 * 8); \
        vr = *(const u32x4*)(vbase + (size_t)((t) * 64 + lane) * 512 + wid * 8); } while (0)
#define ATT_STORE(bf) do { LAS unsigned char* bb_ = lds + (bf) * 22016; *(LAS u32x4*)(bb_ + kk0 * 208 + pc0 * 16) = kr0; if (has1) *(LAS u32x4*)(bb_ + kk1 * 208 + pc1 * 16) = kr1; \
        LAS unsigned char* vv_ = bb_ + 13312 + (wid * 8) * 136 + lane * 2; \
        *(LAS bf16_t*)(vv_) = (bf16_t)vr.x; *(LAS bf16_t*)(vv_ + 136) = (bf16_t)(vr.x >> 16); *(LAS bf16_t*)(vv_ + 2 * 136) = (bf16_t)vr.y; *(LAS bf16_t*)(vv_ + 3 * 136) = (bf16_t)(vr.y >> 16); \
        *(LAS bf16_t*)(vv_ + 4 * 136) = (bf16_t)vr.z; *(LAS bf16_t*)(vv_ + 5 * 136) = (bf16_t)(vr.z >> 16); *(LAS bf16_t*)(vv_ + 6 * 136) = (bf16_t)vr.w; *(LAS bf16_t*)(vv_ + 7 * 136) = (bf16_t)(vr.w >> 16); } while (0)
    ATT_LOAD(0); ATT_STORE(0); __syncthreads();
    for (int t = 0; t < NT; ++t) {
        if (t + 1 < NT) ATT_LOAD(t + 1);
        if (t <= cw) {
            const LAS unsigned char* kb = lds + (t & 1) * 22016; const LAS unsigned char* vb = kb + 13312;
            f32x16 p0 = {}, p1v = {};
#pragma unroll
            for (int ds = 0; ds < 6; ++ds) { const bf16x8 a0 = *(const LAS bf16x8*)(kb + r32 * 208 + (ds * 16 + hi * 8) * 2), a1 = *(const LAS bf16x8*)(kb + (32 + r32) * 208 + (ds * 16 + hi * 8) * 2);
                p0 = __builtin_amdgcn_mfma_f32_32x32x16_bf16(a0, qf[ds], p0, 0, 0, 0); p1v = __builtin_amdgcn_mfma_f32_32x32x16_bf16(a1, qf[ds], p1v, 0, 0, 0); }
            float mx = fmaxf(p0[0], p1v[0]);
#pragma unroll
            for (int r = 1; r < 16; ++r) mx = fmaxf(mx, fmaxf(p0[r], p1v[r]));
            mx = fmaxf(mx, __shfl_xor(mx, 32));
            const float mn = fmaxf(mrun, mx), alpha = fexp2(mrun - mn); mrun = mn;
            float rs = 0.f;
#pragma unroll
            for (int r = 0; r < 16; ++r) { p0[r] = fexp2(p0[r] - mn); p1v[r] = fexp2(p1v[r] - mn); rs += p0[r] + p1v[r]; }
            lrun = lrun * alpha + rs;
#pragma unroll
            for (int r = 0; r < 16; ++r) { o0[r] *= alpha; o1[r] *= alpha; }
            bf16x8 pf[4];
            { u32x4 w;
              w.x = cvt_pk_bf16(p0[0], p0[1]); w.y = cvt_pk_bf16(p0[2], p0[3]); w.z = cvt_pk_bf16(p0[4], p0[5]); w.w = cvt_pk_bf16(p0[6], p0[7]); pf[0] = __builtin_bit_cast(bf16x8, w);
              w.x = cvt_pk_bf16(p0[8], p0[9]); w.y = cvt_pk_bf16(p0[10], p0[11]); w.z = cvt_pk_bf16(p0[12], p0[13]); w.w = cvt_pk_bf16(p0[14], p0[15]); pf[1] = __builtin_bit_cast(bf16x8, w);
              w.x = cvt_pk_bf16(p1v[0], p1v[1]); w.y = cvt_pk_bf16(p1v[2], p1v[3]); w.z = cvt_pk_bf16(p1v[4], p1v[5]); w.w = cvt_pk_bf16(p1v[6], p1v[7]); pf[2] = __builtin_bit_cast(bf16x8, w);
              w.x = cvt_pk_bf16(p1v[8], p1v[9]); w.y = cvt_pk_bf16(p1v[10], p1v[11]); w.z = cvt_pk_bf16(p1v[12], p1v[13]); w.w = cvt_pk_bf16(p1v[14], p1v[15]); pf[3] = __builtin_bit_cast(bf16x8, w); }
#pragma unroll
            for (int ks = 0; ks < 4; ++ks) {
                { const u32x2 lo = *(const LAS u32x2*)(vb + r32 * 136 + (16 * ks + 4 * hi) * 2), hh = *(const LAS u32x2*)(vb + r32 * 136 + (16 * ks + 8 + 4 * hi) * 2);
                  const u32x4 w = {lo.x, lo.y, hh.x, hh.y}; o0 = __builtin_amdgcn_mfma_f32_32x32x16_bf16(__builtin_bit_cast(bf16x8, w), pf[ks], o0, 0, 0, 0); }
                { const u32x2 lo = *(const LAS u32x2*)(vb + (32 + r32) * 136 + (16 * ks + 4 * hi) * 2), hh = *(const LAS u32x2*)(vb + (32 + r32) * 136 + (16 * ks + 8 + 4 * hi) * 2);
                  const u32x4 w = {lo.x, lo.y, hh.x, hh.y}; o1 = __builtin_amdgcn_mfma_f32_32x32x16_bf16(__builtin_bit_cast(bf16x8, w), pf[ks], o1, 0, 0, 0); }
            }
        }
        if (t + 1 < NT) ATT_STORE((t + 1) & 1);
        __syncthreads();
    }
#undef ATT_LOAD
#undef ATT_STORE
    const float linv = 1.0f / (lrun + __shfl_xor(lrun, 32));
    bf16_t* op = C.qb() + qrow * QW + h * 64 + 4 * hi;
#pragma unroll
    for (int g4 = 0; g4 < 4; ++g4) {
        u32x2 w; w.x = cvt_pk_bf16(o0[4 * g4] * linv, o0[4 * g4 + 1] * linv); w.y = cvt_pk_bf16(o0[4 * g4 + 2] * linv, o0[4 * g4 + 3] * linv); *(u32x2*)(op + 8 * g4) = w;
        w.x = cvt_pk_bf16(o1[4 * g4] * linv, o1[4 * g4 + 1] * linv); w.y = cvt_pk_bf16(o1[4 * g4 + 2] * linv, o1[4 * g4 + 3] * linv); *(u32x2*)(op + 32 + 8 * g4) = w;
    }
}
__device__ __forceinline__ void attn_phase(const Ctx& C, LAS unsigned char* lds) {
    for (int pi = blockIdx.x; pi < 256; pi += gridDim.x) {
        const int xcd = pi & 7, k = pi >> 3, bh = xcd * 4 + (k >> 3), j = k & 7, b = bh >> 3, h = bh & 7;
        attn_unit(C, b, h, 15 - j, lds);
        attn_unit(C, b, h, j, lds);
    }
}

__global__ void __launch_bounds__(512, 2) fwd_megakernel(Params P) {
    extern __shared__ __attribute__((aligned(16))) unsigned char lds_raw[];
    LAS unsigned char* lds = (LAS unsigned char*)lds_raw;
    cg::grid_group grid = cg::this_grid();
    const int G = gridDim.x, cid = blockIdx.x;

    { NEWCTX;
#if !defined(NO_CONV)
      convert_layer(C, 0, lds);
#endif
    }
    { NEWCTX;
#if !defined(NO_ADA)
      ada_tables(C, lds);
#endif
    }
    grid.sync();
    { NEWCTX; mod_x0(C); }
    grid.sync();

#pragma unroll 1
    for (int l = 0; l < DEPTH; ++l) {
        pg8::StaticOrder S;
        { NEWCTX; pg8::Gemm g{C.hb(), C.w_in(), MTOK, INP, 1024, 1024}; S.init(MTOK, INP, G, cid); EpiProj E{C.proj(), C.b_inp()}; pg8::gemm_phase(lds, g, S, E); }
        grid.sync();
        { NEWCTX;
#if !defined(NO_PRE)
          token_prepass(C);
#endif
        }
        grid.sync();
        { NEWCTX; pg8::Gemm g{C.proj() + O_CQ, C.w_q(), MTOK, 768, 384, INP}; S.init(MTOK, 768, G, cid); EpiQ E{C.qb(), C.rstd_q()}; pg8::gemm_phase(lds, g, S, E); }
        { NEWCTX; pg8::Gemm g{C.proj() + O_CKV, C.w_kv(), MTOK, 1024, 256, INP}; S.init(MTOK, 1024, G, cid); EpiKV E{C.kf(), C.vt(), C.rstd_kv()}; pg8::gemm_phase(lds, g, S, E); }
        __syncthreads();
        { NEWCTX;
#if !defined(NO_SGU)
          sgu_phase(C, l, lds);
#endif
        }
        { NEWCTX;
#if !defined(NO_S5)
          s5_phase<false>(C, l, lds);
#endif
        }
        grid.sync();
        { NEWCTX;
#if !defined(NO_ATT)
          attn_phase(C, lds);
#endif
        }
        __syncthreads();
        { NEWCTX;
#if !defined(NO_S5)
          s5_phase<true>(C, l, lds);
#endif
        }
        grid.sync();
        { NEWCTX; pg8::Gemm g{C.zb(), C.w_glu(), MTOK, 512, 512, 512}; S.init(MTOK, 512, G, cid); EpiGlu E{C.zb(), C.proj(), C.in(15) + l * 512}; pg8::gemm_phase(lds, g, S, E); }
        grid.sync();
        S.init(MTOK, 1024, G, cid);
        { NEWCTX; pg8::Gemm g{C.proj() + O_US5, C.w_br(), MTOK, 1024, 512, INP}; EpiBranch<0> E{C.proj() + O_GATE, C.pre(), C.merged()}; pg8::gemm_phase(lds, g, S, E); }
        { NEWCTX; pg8::Gemm g{C.qb(), C.w_br() + (size_t)1024 * 512, MTOK, 1024, 512, QW}; EpiBranch<1> E{C.proj() + O_GATE + 1024, C.pre(), C.merged()}; pg8::gemm_phase(lds, g, S, E); }
        { NEWCTX; pg8::Gemm g{C.proj() + O_USGU, C.w_br() + (size_t)2 * 1024 * 512, MTOK, 1024, 512, INP}; EpiBranch<2> E{C.proj() + O_GATE + 2048, C.pre(), C.merged()}; pg8::gemm_phase(lds, g, S, E); }
        grid.sync();
        { NEWCTX; const float* xres = (l == 0) ? C.in(0) : C.xcur();
          pg8::Gemm g{C.merged(), C.w_out(), MTOK, 1024, 1024, 1024}; EpiRes E{xres, C.pre(), C.ada() + (size_t)l * 4 * 6144 + 2048}; pg8::gemm_phase(lds, g, S, E); }
        grid.sync();
        { NEWCTX; const float* ada_l = C.ada() + (size_t)l * 4 * 6144; ln_pass(C.pre(), C.in(26) + l * 1024, C.in(27) + l * 1024, C.xcur(), C.hb(), ada_l + 3072, ada_l + 4096); }
        grid.sync();
        { NEWCTX; pg8::Gemm g{C.hb(), C.w_f1(), MTOK, FF2, 1024, 1024}; pg8::StaticOrder S2; S2.init(MTOK, FF2, G, cid); EpiFfn1 E{C.hid()}; pg8::gemm_phase(lds, g, S2, E); }
        grid.sync();
        { NEWCTX; pg8::Gemm g{C.hid(), C.w_f2(), MTOK, 1024, FF, FF}; EpiRes E{C.xcur(), C.pre(), C.ada() + (size_t)l * 4 * 6144 + 5120}; pg8::gemm_phase(lds, g, S, E); }
        grid.sync();
        if (l + 1 < DEPTH) {
            { NEWCTX; const float* ada_n = C.ada() + (size_t)(l + 1) * 4 * 6144; ln_pass(C.pre(), C.in(30) + l * 1024, C.in(31) + l * 1024, C.xcur(), C.hb(), ada_n, ada_n + 1024); }
            __syncthreads();
            { NEWCTX;
#if !defined(NO_CONV)
              convert_layer(C, l + 1, lds);
#endif
            }
        } else { NEWCTX; ln_pass(C.pre(), C.in(30) + l * 1024, C.in(31) + l * 1024, C.out(), nullptr, nullptr, nullptr); }
        grid.sync();
    }
}

extern "C" void kernel_launch(void* const* d_in, const int* in_sizes, int n_in, void* d_out, int out_size, void* d_ws, size_t ws_size, hipStream_t stream) {
    static int grid_blocks = 0;
    if (grid_blocks == 0) {
        if (n_in != 32 || out_size != MTOK * DM || ws_size < WS_END) { fprintf(stderr, "kernel_launch: unexpected problem (n_in %d out %d ws %zu need %zu)\n", n_in, out_size, ws_size, (size_t)WS_END); grid_blocks = -1; return; }
        int dev = 0, cus = 0, per_cu = 0;
        hipGetDevice(&dev);
        hipDeviceGetAttribute(&cus, hipDeviceAttributeMultiprocessorCount, dev);
        hipFuncSetAttribute((const void*)fwd_megakernel, hipFuncAttributeMaxDynamicSharedMemorySize, LDS_BYTES);
        hipOccupancyMaxActiveBlocksPerMultiprocessor(&per_cu, (const void*)fwd_megakernel, 512, LDS_BYTES);
        if (per_cu < 1) per_cu = 1;
        grid_blocks = cus * per_cu;
        (void)hipGetLastError();
    }
    if (grid_blocks < 0) return;
    Params p{};
    for (int i = 0; i < 32; ++i) p.in[i] = (const float*)d_in[i];
    p.out = (float*)d_out; p.ws = (unsigned char*)d_ws;
    void* args[] = {&p};
    hipError_t e = hipLaunchCooperativeKernel((const void*)fwd_megakernel, dim3(grid_blocks), dim3(512), args, LDS_BYTES, stream);
    if (e != hipSuccess) fprintf(stderr, "cooperative launch failed: %s (grid %d)\n", hipGetErrorString(e), grid_blocks);
}
```

```cpp
#include <hip/hip_runtime.h>
#include <hip/hip_cooperative_groups.h>
#include <cstdint>
#include <cstdio>
namespace cg = cooperative_groups;

#define LAS __attribute__((address_space(3)))
typedef unsigned short bf16_t;
typedef short bf16x8 __attribute__((ext_vector_type(8)));
typedef float f32x4 __attribute__((ext_vector_type(4)));
typedef float f32x16 __attribute__((ext_vector_type(16)));
typedef unsigned u32x4 __attribute__((ext_vector_type(4)));
typedef unsigned u32x2 __attribute__((ext_vector_type(2)));

constexpr int SEQ = 4096, MTOK = 16384, DM = 1024, DEPTH = 4;
constexpr int INW = 5280, INP = 5376;
constexpr int O_US5 = 0, O_CQ = 512, O_CKV = 896, O_KPE = 1152, O_USGU = 1184, O_VSGU = 1696, O_GATE = 2208;
constexpr int FF = 2816, FF2 = 5632, QW = 768;
constexpr float ALPHA = 1.681792830507429f;
constexpr float QSCALE = 0.14724444602590306f;
constexpr int LDS_PHASE = 135168;
constexpr int LDS_BYTES = LDS_PHASE + 16;

constexpr size_t al256(size_t x) { return (x + 255) & ~(size_t)255; }
constexpr size_t WS_W_IN = 0;
constexpr size_t WS_W_Q = WS_W_IN + (size_t)INP * 1024 * 2;
constexpr size_t WS_W_KV = WS_W_Q + (size_t)768 * 384 * 2;
constexpr size_t WS_W_GLU = WS_W_KV + (size_t)1024 * 256 * 2;
constexpr size_t WS_W_BR = WS_W_GLU + (size_t)512 * 512 * 2;
constexpr size_t WS_W_OUT = WS_W_BR + (size_t)3 * 1024 * 512 * 2;
constexpr size_t WS_W_F1 = WS_W_OUT + (size_t)1024 * 1024 * 2;
constexpr size_t WS_W_F2 = WS_W_F1 + (size_t)FF2 * 1024 * 2;
constexpr size_t WS_B_INP = WS_W_F2 + (size_t)1024 * FF * 2;
constexpr size_t WS_SGUW = WS_B_INP + (size_t)INP * 4;
constexpr size_t WS_S5BB = WS_SGUW + (size_t)4 * 128 * 128 * 2;
constexpr size_t WS_S5CM = WS_S5BB + (size_t)32 * 128 * 16 * 2;
constexpr size_t WS_S5A = WS_S5CM + (size_t)32 * 16 * 128 * 2;
constexpr size_t WS_S5A64 = WS_S5A + (size_t)32 * 64 * 2 * 4;
constexpr size_t WS_ADA = al256(WS_S5A64 + (size_t)32 * 64 * 2 * 4);
constexpr size_t WS_COS = WS_ADA + (size_t)4 * 4 * 6144 * 4;
constexpr size_t WS_SIN = WS_COS + (size_t)4096 * 16 * 4;
constexpr size_t WS_STAT = WS_SIN + (size_t)4096 * 16 * 4;
constexpr size_t WS_EBUF = WS_STAT + (size_t)4 * 16384 * 4;
constexpr size_t WS_PROJ = al256(WS_EBUF + (size_t)256 * 32 * 128 * 4);
constexpr size_t WS_XCUR = WS_PROJ + (size_t)MTOK * INP * 2;
constexpr size_t WS_PRE = WS_XCUR + (size_t)MTOK * DM * 4;
constexpr size_t WS_KF = WS_PRE;
constexpr size_t WS_VT = WS_KF + (size_t)MTOK * QW * 2;
constexpr size_t WS_Z = WS_VT + (size_t)2048 * 4096 * 2;
constexpr size_t WS_HB = WS_PRE + (size_t)MTOK * DM * 4;
constexpr size_t WS_QB = WS_HB + (size_t)MTOK * DM * 2;
constexpr size_t WS_BAR = WS_QB + (size_t)MTOK * QW * 2;
constexpr size_t WS_END = WS_BAR + 16384;
static_assert(WS_Z + (size_t)MTOK * 512 * 2 <= WS_HB, "overlay");

#ifndef PROBE_MASK
#define PROBE_MASK 0
#endif
#define REP(bit) for (int rep_ = 0; rep_ < (((PROBE_MASK) >> (bit)) & 1) + 1; ++rep_)
__device__ __forceinline__ unsigned cvt_pk_bf16(float lo, float hi) { unsigned r; asm volatile("v_cvt_pk_bf16_f32 %0, %1, %2" : "=v"(r) : "v"(lo), "v"(hi)); return r; }
__device__ __forceinline__ bf16_t f2bf(float x) { return (bf16_t)(cvt_pk_bf16(x, 0.f) & 0xffffu); }
__device__ __forceinline__ float bf2f(bf16_t v) { return __uint_as_float((unsigned)v << 16); }
__device__ __forceinline__ float bflo(unsigned w) { return __uint_as_float(w << 16); }
__device__ __forceinline__ float bfhi(unsigned w) { return __uint_as_float(w & 0xffff0000u); }
__device__ __forceinline__ float fexp2(float x) { return __builtin_amdgcn_exp2f(x); }
__device__ __forceinline__ float frcp(float x) { return __builtin_amdgcn_rcpf(x); }
__device__ __forceinline__ float sigmoidf_(float x) { return frcp(1.0f + fexp2(-1.4426950408889634f * x)); }
__device__ __forceinline__ float siluf_(float x) { return x * sigmoidf_(x); }
__device__ __forceinline__ float geluf_(float x) { const float u = 1.5957691216057308f * (x + 0.044715f * x * x * x); return x * sigmoidf_(u); }
__device__ __forceinline__ float wave_sum(float v) {
#pragma unroll
    for (int o = 32; o > 0; o >>= 1) v += __shfl_xor(v, o);
    return v;
}
__device__ __forceinline__ void sincos_rr(float x, float& s, float& c) {
    const float k = rintf(x * 0.15915494309189535f);
    float r = fmaf(-k, 6.2831854820251465f, x);
    r = fmaf(-k, -1.7484555e-07f, r);
    s = sinf(r); c = cosf(r);
}
__device__ const float INV_FREQ[16] = {1.000000000e+00f, 5.623413324e-01f, 3.162277639e-01f, 1.778279394e-01f, 1.000000015e-01f, 5.623412877e-02f, 3.162277862e-02f, 1.778279431e-02f,
                                       9.999999776e-03f, 5.623413250e-03f, 3.162277862e-03f, 1.778279431e-03f, 1.000000047e-03f, 5.623413017e-04f, 3.162277862e-04f, 1.778279402e-04f};

namespace pg8 {
constexpr int BM = 256, BK = 64, HALF = 128, HTB = HALF * BK * 2, STAGE_BYTES = 8 * HTB, NXCD = 8, WGM = 8;
__device__ __forceinline__ int lds_byte(int r, int c) { const int st = (r >> 4) * 2 + (c >> 5), rr = r & 15, cc = c & 31, ob = rr * 64 + cc * 2; return st * 1024 + (ob ^ (((ob >> 9) & 1) << 5)); }
__device__ __forceinline__ void stage_rc(int b, int& R, int& C) { const int st = b / 1024, sb = b % 1024, swz = sb ^ (((sb >> 9) & 1) << 5); R = (st >> 1) * 16 + swz / 64; C = (st & 1) * 32 + (swz % 64) / 2; }
__device__ __forceinline__ int perm32(int rho) { const int n = rho >> 4, i = rho & 15; return 8 * (i >> 2) + 4 * n + (i & 3); }
struct Unit { int pm, pn; };
struct Gemm { const bf16_t* A; const bf16_t* Bt; int M, N, K, lda; };
struct StaticOrder {
    int nM, nN, nwg, G, c;
    __device__ void init(int M, int N, int G_, int c_) { nM = M / BM; nN = N / BM; nwg = nM * nN; G = G_; c = c_; }
    __device__ bool next(int i, Unit& u) const {
        const long L = (long)i * G + c; if (L >= nwg) return false;
        int wgid = (int)L; { const int q = nwg / NXCD, r = nwg % NXCD, xcd = wgid % NXCD, off = wgid / NXCD; wgid = (xcd < r ? xcd * (q + 1) : r * (q + 1) + (xcd - r) * q) + off; }
        const int nig = WGM * nN, gid = wgid / nig, fm = gid * WGM, gsz = (nM - fm) < WGM ? (nM - fm) : WGM;
        u.pm = fm + ((wgid % nig) % gsz); u.pn = (wgid % nig) / gsz; return true;
    }
};
template <class Epi>
__device__ __forceinline__ void gemm_phase(LAS unsigned char* lds, const Gemm g, const StaticOrder& S, const Epi& E) {
#if defined(NO_GEMM)
    return;
#endif
    int tid = threadIdx.x; asm volatile("" : "+v"(tid));
    const int wid = __builtin_amdgcn_readfirstlane(tid >> 6), lane = tid & 63, wr = wid >> 2, wc = wid & 3, fr = lane & 15, fq = lane >> 4;
    const int K = g.K, nt = K / BK, lda = g.lda;
    unsigned voffA[2], voffB[2];
#pragma unroll
    for (int i = 0; i < 2; ++i) { int R, C; stage_rc(tid * 16 + i * 8192, R, C); const int Rb = Epi::PERM ? ((R & ~31) + perm32(R & 31)) : R;
        voffA[i] = (unsigned)(R * lda + C) * 2u; voffB[i] = (unsigned)(Rb * K + C) * 2u; }
    const size_t kstep = (size_t)(BK * 2);
    const size_t hstepA = (size_t)HALF * lda * 2, hstepB = (size_t)HALF * K * 2;
    const size_t tstepA = 2 * hstepA, tstepB = 2 * hstepB;
    const unsigned ldsw = (unsigned)wid * 1024u;
    const int aoff = lds_byte(wr * 64 + fr, fq * 8), boff = lds_byte(wc * 32 + fr, fq * 8);
#define PG8_SA(b, h) (((b) * 2 + (h)) * HTB)
#define PG8_SB(b, h) ((4 + (b) * 2 + (h)) * HTB)
#define PG8_STAGE(bufoff, gbase, voff) do { _Pragma("unroll") for (int _i = 0; _i < 2; ++_i) \
        __builtin_amdgcn_global_load_lds((const unsigned*)((const char*)(gbase) + (voff)[_i]), (LAS unsigned*)(lds + (bufoff) + ldsw + _i * 8192), 16, 0, 0); } while (0)
#define PG8_LDA(dst, b, h) do { _Pragma("unroll") for (int m = 0; m < 4; ++m) _Pragma("unroll") for (int k = 0; k < 2; ++k) dst[m][k] = *(const LAS bf16x8*)(lds + PG8_SA(b, h) + aoff + m * 2048 + k * 1024); } while (0)
#define PG8_LDB(dst, b, h) do { _Pragma("unroll") for (int n = 0; n < 2; ++n) _Pragma("unroll") for (int k = 0; k < 2; ++k) dst[n][k] = *(const LAS bf16x8*)(lds + PG8_SB(b, h) + boff + n * 2048 + k * 1024); } while (0)
#define PG8_MMA(ai, bj, At, Bt) do { __builtin_amdgcn_s_setprio(1); _Pragma("unroll") for (int m = 0; m < 4; ++m) _Pragma("unroll") for (int n = 0; n < 2; ++n) _Pragma("unroll") for (int k = 0; k < 2; ++k) \
        acc[ai][bj][m][n] = __builtin_amdgcn_mfma_f32_16x16x32_bf16(Bt[n][k], At[m][k], acc[ai][bj][m][n], 0, 0, 0); __builtin_amdgcn_s_setprio(0); } while (0)
#define PG8_WAIT_V(n) asm volatile("s_waitcnt vmcnt(" #n ")" ::: "memory")
#define PG8_WAIT_L(n) asm volatile("s_waitcnt lgkmcnt(" #n ")" ::: "memory")
#define PG8_BAR __builtin_amdgcn_s_barrier()
#define PG8_SCHED __builtin_amdgcn_sched_barrier(0)
    Unit cur, nxt; int ui = 0;
    if (!S.next(0, cur)) return;
    f32x4 acc[2][2][4][2];
#pragma unroll
    for (int a = 0; a < 2; ++a)
#pragma unroll
        for (int b = 0; b < 2; ++b)
#pragma unroll
            for (int m = 0; m < 4; ++m)
#pragma unroll
                for (int n = 0; n < 2; ++n) acc[a][b][m][n] = (f32x4){0.f, 0.f, 0.f, 0.f};
    bf16x8 At[4][2], B0[2][2], B1[2][2];
    const char* cA = (const char*)g.A + (size_t)cur.pm * tstepA; const char* cB = (const char*)g.Bt + (size_t)cur.pn * tstepB;
    PG8_STAGE(PG8_SB(0, 0), cB, voffB); PG8_STAGE(PG8_SB(0, 1), cB + hstepB, voffB); PG8_STAGE(PG8_SA(0, 0), cA, voffA); PG8_STAGE(PG8_SA(0, 1), cA + hstepA, voffA);
    if (wr == 1) PG8_BAR;
    PG8_WAIT_V(2); PG8_BAR;
    PG8_STAGE(PG8_SB(1, 0), cB + kstep, voffB); PG8_STAGE(PG8_SA(1, 0), cA + kstep, voffA); PG8_STAGE(PG8_SB(1, 1), cB + hstepB + kstep, voffB);
    PG8_WAIT_V(6); PG8_BAR;
    for (;;) {
        const bool has_next = S.next(ui + 1, nxt);
        const char* nA = has_next ? (const char*)g.A + (size_t)nxt.pm * tstepA : cA; const char* nB = has_next ? (const char*)g.Bt + (size_t)nxt.pn * tstepB : cB;
#pragma unroll 1
        for (int t = 0; t < nt; t += 2) {
            const bool last = (t == nt - 2);
            const char* a1 = cA + (size_t)(t + 1) * kstep;
            const char* a2 = last ? nA : cA + (size_t)(t + 2) * kstep; const char* b2 = last ? nB : cB + (size_t)(t + 2) * kstep;
            const char* a3 = a2 + kstep; const char* b3 = b2 + kstep;
            PG8_LDB(B0, 0, 0); PG8_LDB(B1, 0, 1); PG8_SCHED; PG8_LDA(At, 0, 0); PG8_STAGE(PG8_SA(1, 1), a1 + hstepA, voffA);
            PG8_WAIT_V(8); PG8_WAIT_L(0); PG8_BAR; PG8_MMA(0, 0, At, B0); PG8_MMA(0, 1, At, B1); PG8_BAR; PG8_SCHED;
            PG8_LDA(At, 0, 1); PG8_STAGE(PG8_SB(0, 0), b2, voffB); PG8_STAGE(PG8_SB(0, 1), b2 + hstepB, voffB); PG8_STAGE(PG8_SA(0, 0), a2, voffA);
            PG8_WAIT_V(8); PG8_WAIT_L(0); PG8_BAR; PG8_MMA(1, 0, At, B0); PG8_MMA(1, 1, At, B1); PG8_BAR; PG8_SCHED;
            PG8_LDB(B0, 1, 0); PG8_LDB(B1, 1, 1); PG8_SCHED; PG8_LDA(At, 1, 0); PG8_STAGE(PG8_SA(0, 1), a2 + hstepA, voffA);
            PG8_WAIT_V(8); PG8_WAIT_L(0); PG8_BAR; PG8_MMA(0, 0, At, B0); PG8_MMA(0, 1, At, B1); PG8_BAR; PG8_SCHED;
            PG8_LDA(At, 1, 1); PG8_STAGE(PG8_SB(1, 0), b3, voffB); PG8_STAGE(PG8_SB(1, 1), b3 + hstepB, voffB); PG8_STAGE(PG8_SA(1, 0), a3, voffA);
            PG8_WAIT_V(8); PG8_WAIT_L(0); PG8_BAR; PG8_MMA(1, 0, At, B0); PG8_MMA(1, 1, At, B1); PG8_BAR; PG8_SCHED;
        }
        if (wr == 0) PG8_BAR;
        E(acc, cur, wr, wc, fr, fq);
        if (!has_next) break;
#pragma unroll
        for (int a = 0; a < 2; ++a)
#pragma unroll
            for (int b = 0; b < 2; ++b)
#pragma unroll
                for (int m = 0; m < 4; ++m)
#pragma unroll
                    for (int n = 0; n < 2; ++n) acc[a][b][m][n] = (f32x4){0.f, 0.f, 0.f, 0.f};
        cur = nxt; cA = nA; cB = nB; ++ui;
        if (wr == 1) PG8_BAR;
    }
    PG8_WAIT_V(0);
    PG8_BAR;
#undef PG8_SA
#undef PG8_SB
#undef PG8_STAGE
#undef PG8_LDA
#undef PG8_LDB
#undef PG8_MMA
#undef PG8_WAIT_V
#undef PG8_WAIT_L
#undef PG8_BAR
#undef PG8_SCHED
}
}
using pg8::Unit;
typedef f32x4 AccT[2][2][4][2];

__device__ __forceinline__ u32x4 pack8(const f32x4 a, const f32x4 b) { u32x4 w; w.x = cvt_pk_bf16(a[0], a[1]); w.y = cvt_pk_bf16(a[2], a[3]); w.z = cvt_pk_bf16(b[0], b[1]); w.w = cvt_pk_bf16(b[2], b[3]); return w; }
__device__ __forceinline__ void unpack8(const u32x4 w, f32x4& a, f32x4& b) { a = (f32x4){bflo(w.x), bfhi(w.x), bflo(w.y), bfhi(w.y)}; b = (f32x4){bflo(w.z), bfhi(w.z), bflo(w.w), bfhi(w.w)}; }

struct EpiProj { static constexpr bool PERM = true;
    bf16_t* O; const float* bias;
    __device__ __forceinline__ void operator()(const AccT& acc, const Unit& u, int wr, int wc, int fr, int fq) const {
        const int row0 = u.pm * 256 + wr * 64 + fr, col0 = u.pn * 256 + wc * 32 + 8 * fq;
#pragma unroll
        for (int bj = 0; bj < 2; ++bj) { const f32x4 b0 = *(const f32x4*)(bias + col0 + bj * 128), b1 = *(const f32x4*)(bias + col0 + bj * 128 + 4);
#pragma unroll
            for (int ai = 0; ai < 2; ++ai)
#pragma unroll
                for (int m = 0; m < 4; ++m) { bf16_t* p = O + (size_t)(row0 + ai * 128 + m * 16) * INP + col0 + bj * 128;
                    *(u32x4*)p = pack8(acc[ai][bj][m][0] + b0, acc[ai][bj][m][1] + b1); } }
    }
};
struct EpiQ { static constexpr bool PERM = true;
    bf16_t* Q; const float* rstd;
    __device__ __forceinline__ void operator()(const AccT& acc, const Unit& u, int wr, int wc, int fr, int fq) const {
        const int row0 = u.pm * 256 + wr * 64 + fr, col0 = u.pn * 256 + wc * 32 + 8 * fq;
#pragma unroll
        for (int ai = 0; ai < 2; ++ai)
#pragma unroll
            for (int m = 0; m < 4; ++m) { const int row = row0 + ai * 128 + m * 16; const float sc = rstd[row] * QSCALE;
#pragma unroll
                for (int bj = 0; bj < 2; ++bj) *(u32x4*)(Q + (size_t)row * QW + col0 + bj * 128) = pack8(acc[ai][bj][m][0] * sc, acc[ai][bj][m][1] * sc); }
    }
};
struct EpiKV { static constexpr bool PERM = true;
    bf16_t* Kf; bf16_t* Vn; const float* rstd;
    __device__ __forceinline__ void operator()(const AccT& acc, const Unit& u, int wr, int wc, int fr, int fq) const {
        const int row0 = u.pm * 256 + wr * 64 + fr;
#pragma unroll
        for (int ai = 0; ai < 2; ++ai)
#pragma unroll
            for (int m = 0; m < 4; ++m) { const int row = row0 + ai * 128 + m * 16; const float sc = rstd[row];
#pragma unroll
                for (int bj = 0; bj < 2; ++bj) { const int n0 = u.pn * 256 + bj * 128 + wc * 32 + 8 * fq; const u32x4 w = pack8(acc[ai][bj][m][0] * sc, acc[ai][bj][m][1] * sc);
                    if (u.pn < 2) *(u32x4*)(Kf + (size_t)row * QW + (n0 >> 6) * 96 + (n0 & 63)) = w;
                    else *(u32x4*)(Vn + (size_t)row * 512 + (n0 - 512)) = w; } }
    }
};
struct EpiGlu { static constexpr bool PERM = true;
    const bf16_t* Z; bf16_t* O; const float* bias;
    __device__ __forceinline__ void operator()(const AccT& acc, const Unit& u, int wr, int wc, int fr, int fq) const {
        const int row0 = u.pm * 256 + wr * 64 + fr, col0 = u.pn * 256 + wc * 32 + 8 * fq;
#pragma unroll
        for (int bj = 0; bj < 2; ++bj) { const int col = col0 + bj * 128; const f32x4 b0 = *(const f32x4*)(bias + col), b1 = *(const f32x4*)(bias + col + 4);
#pragma unroll
            for (int ai = 0; ai < 2; ++ai)
#pragma unroll
                for (int m = 0; m < 4; ++m) { const int row = row0 + ai * 128 + m * 16; f32x4 z0, z1; unpack8(*(const u32x4*)(Z + (size_t)row * 512 + col), z0, z1);
                    f32x4 a0 = acc[ai][bj][m][0] + b0, a1 = acc[ai][bj][m][1] + b1;
#pragma unroll
                    for (int j = 0; j < 4; ++j) { a0[j] = z0[j] * sigmoidf_(a0[j]); a1[j] = z1[j] * sigmoidf_(a1[j]); }
                    *(u32x4*)(O + (size_t)row * INP + O_US5 + col) = pack8(a0, a1); asm volatile("" ::: "memory"); } }
    }
};
template <int MODE> struct EpiBranch { static constexpr bool PERM = true;
    const bf16_t* gate; float* macc; bf16_t* merged;
    __device__ __forceinline__ void operator()(const AccT& acc, const Unit& u, int wr, int wc, int fr, int fq) const {
        const int row0 = u.pm * 256 + wr * 64 + fr, col0 = u.pn * 256 + wc * 32 + 8 * fq;
#pragma unroll
        for (int ai = 0; ai < 2; ++ai)
#pragma unroll
            for (int m = 0; m < 4; ++m) { const int row = row0 + ai * 128 + m * 16;
#pragma unroll
                for (int bj = 0; bj < 2; ++bj) { const int col = col0 + bj * 128; f32x4 g0, g1; unpack8(*(const u32x4*)(gate + (size_t)row * INP + col), g0, g1);
                    f32x4 a0 = acc[ai][bj][m][0], a1 = acc[ai][bj][m][1];
#pragma unroll
                    for (int j = 0; j < 4; ++j) { a0[j] *= sigmoidf_(g0[j]); a1[j] *= sigmoidf_(g1[j]); }
                    float* mp = macc + (size_t)row * DM + col;
                    if (MODE >= 1) { a0 += *(const f32x4*)mp; a1 += *(const f32x4*)(mp + 4); }
                    if (MODE <= 1) { *(f32x4*)mp = a0; *(f32x4*)(mp + 4) = a1; }
                    else *(u32x4*)(merged + (size_t)row * DM + col) = pack8(a0, a1); asm volatile("" ::: "memory"); } }
    }
};
struct EpiRes { static constexpr bool PERM = false;
    const float* xres; float* pre; const float* gate;
    __device__ __forceinline__ void operator()(const AccT& acc, const Unit& u, int wr, int wc, int fr, int fq) const {
        const int row0 = u.pm * 256 + wr * 64 + fr, col0 = u.pn * 256 + wc * 32 + 4 * fq; const int b = (u.pm * 256) >> 12;
#pragma unroll
        for (int bj = 0; bj < 2; ++bj)
#pragma unroll
            for (int n = 0; n < 2; ++n) { const int col = col0 + bj * 128 + n * 16; const f32x4 gv = *(const f32x4*)(gate + b * 6144 + col) + 1.0f;
#pragma unroll
                for (int ai = 0; ai < 2; ++ai)
#pragma unroll
                    for (int m = 0; m < 4; ++m) { const size_t off = (size_t)(row0 + ai * 128 + m * 16) * DM + col;
                        const f32x4 xv = *(const f32x4*)(xres + off); *(f32x4*)(pre + off) = xv * ALPHA + gv * acc[ai][bj][m][n]; if (m & 1) asm volatile("" ::: "memory"); } }
    }
};
struct EpiFfn1 { static constexpr bool PERM = true;
    bf16_t* H;
    __device__ __forceinline__ void operator()(const AccT& acc, const Unit& u, int wr, int wc, int fr, int fq) const {
        const int row0 = u.pm * 256 + wr * 64 + fr, hc0 = u.pn * 128 + wc * 16 + 4 * fq;
#pragma unroll
        for (int ai = 0; ai < 2; ++ai)
#pragma unroll
            for (int m = 0; m < 4; ++m) { const int row = row0 + ai * 128 + m * 16;
#pragma unroll
                for (int bj = 0; bj < 2; ++bj) { const f32x4 a = acc[ai][bj][m][0], bb = acc[ai][bj][m][1]; u32x2 w;
                    w.x = cvt_pk_bf16(siluf_(a[0]) * bb[0], siluf_(a[1]) * bb[1]); w.y = cvt_pk_bf16(siluf_(a[2]) * bb[2], siluf_(a[3]) * bb[3]);
                    *(u32x2*)(H + (size_t)row * FF + hc0 + bj * 64) = w; } }
    }
};

#define XB_TMO      128
#define XB_XCNT(j)  (256  + 64 * (j))
#define XB_XSUB(j)  (1280 + 64 * (j))
#define XB_XGEN(j)  (2304 + 64 * (j))
#define XB_TOP      3328
#define XB_TOPGEN   3392
#define XCD_BAR_WORDS 3456
#define XB_SPIN_CAP (1u << 18)

__device__ __forceinline__ unsigned xb_ld(unsigned* p)              { return __hip_atomic_load(p, __ATOMIC_RELAXED, __HIP_MEMORY_SCOPE_AGENT); }
__device__ __forceinline__ unsigned xb_add(unsigned* p, unsigned v) { return __hip_atomic_fetch_add(p, v, __ATOMIC_RELAXED, __HIP_MEMORY_SCOPE_AGENT); }
__device__ __forceinline__ unsigned xb_xcc_id() { return (unsigned)__builtin_amdgcn_s_getreg((3 << 11) | 20) & 0xFu; }
#define XB_SPIN(cond, bar) do { unsigned _sp = 0; while (cond) { __builtin_amdgcn_s_sleep(1); \
    if ((++_sp & 255u) == 0u) { if (xb_ld(&(bar)[XB_TMO])) break; if (_sp > XB_SPIN_CAP) { atomicAdd(&(bar)[XB_TMO], 1u); break; } } } } while (0)

struct XcdBarrier {
    unsigned* bar; unsigned x;
    volatile LAS unsigned* st;
};

__device__ __forceinline__ XcdBarrier xcd_barrier_post(unsigned* bar, volatile LAS unsigned* st) {
    XcdBarrier b; b.bar = bar; b.x = xb_xcc_id(); b.st = st;
    if (threadIdx.x == 0) (void)xb_add(&bar[XB_XCNT(b.x)], 1u);
    return b;
}
__device__ __forceinline__ void xcd_barrier_complete(unsigned* bar, unsigned x, unsigned& nloc, unsigned& nx) {
    const unsigned G = gridDim.x * gridDim.y * gridDim.z;
    unsigned sum, cnt, mine, sp = 0u;
    for (;;) {
        sum = 0u; cnt = 0u; mine = 0u;
#pragma unroll
        for (unsigned j = 0; j < 16; ++j) { const unsigned c = xb_ld(&bar[XB_XCNT(j)]); sum += c; cnt += (c > 0u) ? 1u : 0u; mine = (j == x) ? c : mine; }
        if (sum == G) break;
        __builtin_amdgcn_s_sleep(1);
        if ((++sp & 255u) == 0u) { if (xb_ld(&bar[XB_TMO])) break; if (sp > XB_SPIN_CAP) { atomicAdd(&bar[XB_TMO], 1u); break; } }
    }
    nloc = mine > 0u ? mine : 1u; nx = cnt > 0u ? cnt : 1u;
}

__device__ __forceinline__ void xcd_barrier(const XcdBarrier& b) {
    asm volatile("s_waitcnt vmcnt(0)" ::: "memory");
    __syncthreads();
    if (threadIdx.x == 0) {
        unsigned* bar = b.bar;
        __builtin_amdgcn_s_waitcnt(0);
        unsigned nloc = b.st[0], nx = b.st[1];
        if (nloc == 0u) { xcd_barrier_complete(bar, b.x, nloc, nx); b.st[0] = nloc; b.st[1] = nx; }
        const unsigned old = xb_add(&bar[XB_XSUB(b.x)], 1u);
        const unsigned gen = old / nloc;
        if (old + 1u == (gen + 1u) * nloc) {
            __builtin_amdgcn_fence(__ATOMIC_RELEASE, "agent");
            asm volatile("s_waitcnt vmcnt(0)" ::: "memory");
            const unsigned og = xb_add(&bar[XB_TOP], 1u);
            const unsigned tg = og / nx;
            if (og + 1u == (tg + 1u) * nx) xb_add(&bar[XB_TOPGEN], 1u);
            else XB_SPIN(xb_ld(&bar[XB_TOPGEN]) == tg, bar);
            __builtin_amdgcn_fence(__ATOMIC_ACQUIRE, "agent");
            xb_add(&bar[XB_XGEN(b.x)], 1u);
            asm volatile("s_waitcnt vmcnt(0)" ::: "memory");
        } else {
            XB_SPIN(xb_ld(&bar[XB_XGEN(b.x)]) == gen, bar);
            __builtin_amdgcn_fence(__ATOMIC_ACQUIRE, "agent");
            asm volatile("s_waitcnt vmcnt(0)" ::: "memory");
        }
    }
    __syncthreads();
}

struct Params {
    const float* in[32];
    float* out;
    unsigned char* ws;
};
typedef const __attribute__((address_space(4))) unsigned char* kaptr_t;
typedef const __attribute__((address_space(4))) unsigned long long* kau64_t;
struct Ctx {
    kaptr_t ka;
    __device__ __forceinline__ const float* in(int k) const { return (const float*)(*(kau64_t)(ka + 8 * k)); }
    __device__ __forceinline__ float* out() const { return (float*)(*(kau64_t)(ka + 256)); }
    __device__ __forceinline__ unsigned char* wsb() const { return (unsigned char*)(*(kau64_t)(ka + 264)); }
#define WSP_(T, name, off) __device__ __forceinline__ T* name() const { return (T*)(wsb() + (off)); }
    WSP_(bf16_t, w_in, WS_W_IN) WSP_(bf16_t, w_q, WS_W_Q) WSP_(bf16_t, w_kv, WS_W_KV) WSP_(bf16_t, w_glu, WS_W_GLU) WSP_(bf16_t, w_br, WS_W_BR) WSP_(bf16_t, w_out, WS_W_OUT)
    WSP_(bf16_t, w_f1, WS_W_F1) WSP_(bf16_t, w_f2, WS_W_F2) WSP_(bf16_t, sguw, WS_SGUW) WSP_(bf16_t, s5bb, WS_S5BB) WSP_(bf16_t, s5cm, WS_S5CM)
    WSP_(float, b_inp, WS_B_INP) WSP_(float, s5a, WS_S5A) WSP_(float, s5a64, WS_S5A64) WSP_(float, ada, WS_ADA) WSP_(float, cosT, WS_COS) WSP_(float, sinT, WS_SIN)
    WSP_(float, rstd_q, WS_STAT) WSP_(float, rstd_kv, WS_STAT + 65536) WSP_(float, sgu_mean, WS_STAT + 131072) WSP_(float, sgu_rstd, WS_STAT + 196608) WSP_(float, ebuf, WS_EBUF)
    WSP_(float, xcur, WS_XCUR) WSP_(float, pre, WS_PRE) WSP_(bf16_t, proj, WS_PROJ) WSP_(bf16_t, hid, WS_PROJ) WSP_(bf16_t, kf, WS_KF) WSP_(bf16_t, vt, WS_VT) WSP_(bf16_t, zb, WS_Z)
    WSP_(bf16_t, hb, WS_HB) WSP_(bf16_t, merged, WS_HB) WSP_(bf16_t, qb, WS_QB)
#undef WSP_
};
__device__ __forceinline__ Ctx mk_ctx() { kaptr_t ka = (kaptr_t)__builtin_amdgcn_kernarg_segment_ptr(); asm volatile("" : "+s"(ka)); return Ctx{ka}; }
#define NEWCTX const Ctx C = mk_ctx()

template <int PERMT> __device__ __forceinline__ int perm_src(int n) {
    if (PERMT == 1) { return n < 512 ? (n >> 6) * 96 + (n & 63) : ((n - 512) >> 5) * 96 + 64 + ((n - 512) & 31); }
    if (PERMT == 2) { return n < 512 ? (n >> 6) * 128 + (n & 63) : ((n - 512) >> 6) * 128 + 64 + ((n - 512) & 63); }
    if (PERMT == 3) { const int q = n >> 3, r = n & 7; return r < 4 ? q * 4 + r : FF + q * 4 + (r - 4); }
    return n;
}
template <int PERMT> __device__ __forceinline__ void cvt_weight(const float* src, bf16_t* dst, const float* scale, int K, int Nsrc, int Nout, LAS unsigned char* lds) {
    LAS float* T = (LAS float*)lds;
    int tid = threadIdx.x; asm volatile("" : "+v"(tid));
    const int tk = K >> 6, tn = Nout >> 6, ntile = tk * tn;
    const int rk = tid >> 4, rq = tid & 15;
    const int wn = tid >> 3, wq = tid & 7;
#pragma unroll 1
    for (int t = blockIdx.x; t < ntile; t += gridDim.x) {
        const int k0 = (t % tk) * 64, n0 = (t / tk) * 64;
        const int sc = perm_src<PERMT>(n0 + rq * 4);
#pragma unroll
        for (int i = 0; i < 2; ++i) { const int kk = rk + 32 * i; f32x4 v = {0.f, 0.f, 0.f, 0.f};
            if (sc < Nsrc) v = *(const f32x4*)(src + (size_t)(k0 + kk) * Nsrc + sc);
            if (scale) v = v * scale[k0 + kk];
            *(LAS f32x4*)(T + kk * 68 + rq * 4) = v; }
        __syncthreads();
        { float e[8];
#pragma unroll
          for (int j = 0; j < 8; ++j) e[j] = T[(wq * 8 + j) * 68 + wn];
          u32x4 w; w.x = cvt_pk_bf16(e[0], e[1]); w.y = cvt_pk_bf16(e[2], e[3]); w.z = cvt_pk_bf16(e[4], e[5]); w.w = cvt_pk_bf16(e[6], e[7]);
          *(u32x4*)(dst + (size_t)(n0 + wn) * K + k0 + wq * 8) = w; }
        __syncthreads();
    }
}
__device__ __forceinline__ void convert_layer(const Ctx& C, int l, LAS unsigned char* lds) {
    cvt_weight<0>(C.in(4) + (size_t)l * 1024 * INW, C.w_in(), nullptr, 1024, INW, INP, lds);
    cvt_weight<1>(C.in(17) + (size_t)l * 384 * 768, C.w_q(), C.in(16) + l * 384, 384, 768, 768, lds);
    cvt_weight<2>(C.in(19) + (size_t)l * 256 * 1024, C.w_kv(), C.in(18) + l * 256, 256, 1024, 1024, lds);
    cvt_weight<0>(C.in(14) + (size_t)l * 512 * 512, C.w_glu(), nullptr, 512, 512, 512, lds);
#pragma unroll 1
    for (int b = 0; b < 3; ++b) cvt_weight<0>(C.in(24) + ((size_t)l * 3 + b) * 512 * 1024, C.w_br() + (size_t)b * 1024 * 512, nullptr, 512, 1024, 1024, lds);
    cvt_weight<0>(C.in(25) + (size_t)l * 1024 * 1024, C.w_out(), nullptr, 1024, 1024, 1024, lds);
    cvt_weight<3>(C.in(28) + (size_t)l * 1024 * FF2, C.w_f1(), nullptr, 1024, FF2, FF2, lds);
    cvt_weight<0>(C.in(29) + (size_t)l * FF * 1024, C.w_f2(), nullptr, FF, 1024, 1024, lds);
    int tid2 = threadIdx.x; asm volatile("" : "+v"(tid2));
    const int gt = blockIdx.x * 512 + tid2, gs = gridDim.x * 512;
    for (int i = gt; i < INP; i += gs) C.b_inp()[i] = i < INW ? C.in(5)[(size_t)l * INW + i] : 0.f;
    for (int i = gt; i < 4 * 128 * 128; i += gs) { const int ii = (i >> 7) & 127, jj = i & 127; C.sguw()[i] = f2bf(((jj >> 6) <= (ii >> 6)) ? C.in(22)[(size_t)l * 65536 + i] : 0.f); }
#pragma unroll 1
    for (int i = gt; i < 2048; i += gs) {
        const int g = i >> 6, p = i & 63;
        const float dt = expf(C.in(8)[l * 32 + g]), lr = C.in(6)[l * 2048 + i], li = C.in(7)[l * 2048 + i];
        const float mag = expf(lr * dt); float sn, cs; sincos_rr(li * dt, sn, cs);
        const float are = mag * cs, aim = mag * sn, den = lr * lr + li * li;
        const float fre = ((are - 1.0f) * lr + aim * li) / den, fim = (aim * lr - (are - 1.0f) * li) / den;
        const float* br = C.in(9) + (size_t)l * 32768 + (size_t)i * 16; const float* bi = C.in(10) + (size_t)l * 32768 + (size_t)i * 16;
#pragma unroll
        for (int c = 0; c < 16; ++c) { const float r_ = br[c], i_ = bi[c];
            C.s5bb()[(size_t)(g * 128 + p) * 16 + c] = f2bf(fre * r_ - fim * i_); C.s5bb()[(size_t)(g * 128 + 64 + p) * 16 + c] = f2bf(fre * i_ + fim * r_); }
        C.s5a()[i * 2] = are; C.s5a()[i * 2 + 1] = aim;
        float pr = are, pi = aim;
#pragma unroll
        for (int s = 0; s < 6; ++s) { const float nr = pr * pr - pi * pi, ni = 2.0f * pr * pi; pr = nr; pi = ni; }
        C.s5a64()[i * 2] = pr; C.s5a64()[i * 2 + 1] = pi;
        const float* cr = C.in(11) + (size_t)l * 32768 + (size_t)g * 1024 + p; const float* ci = C.in(12) + (size_t)l * 32768 + (size_t)g * 1024 + p;
#pragma unroll
        for (int c = 0; c < 16; ++c) { C.s5cm()[(size_t)(g * 16 + c) * 128 + p] = f2bf(cr[c * 64]); C.s5cm()[(size_t)(g * 16 + c) * 128 + 64 + p] = f2bf(-ci[c * 64]); }
    }
}
__device__ __forceinline__ void ada_tables(const Ctx& C, LAS unsigned char* lds) {
    LAS float* cact = (LAS float*)lds;
    LAS float* red = (LAS float*)(lds + 16384);
    const int tid = threadIdx.x, lane = tid & 63, wid = tid >> 6;
    for (int i = tid; i < 4096; i += 512) cact[i] = siluf_(C.in(1)[i]);
    __syncthreads();
    for (int u = blockIdx.x; u < 4 * 96; u += gridDim.x) {
        const int l = u / 96, n = (u % 96) * 64 + lane;
        const float* w = C.in(2) + (size_t)l * 1024 * 6144 + n;
        float a0 = 0.f, a1 = 0.f, a2 = 0.f, a3 = 0.f;
        for (int k = wid * 128; k < wid * 128 + 128; ++k) { const float wv = w[(size_t)k * 6144]; a0 += cact[k] * wv; a1 += cact[1024 + k] * wv; a2 += cact[2048 + k] * wv; a3 += cact[3072 + k] * wv; }
        red[(wid * 4 + 0) * 64 + lane] = a0; red[(wid * 4 + 1) * 64 + lane] = a1; red[(wid * 4 + 2) * 64 + lane] = a2; red[(wid * 4 + 3) * 64 + lane] = a3;
        __syncthreads();
        if (tid < 256) { const int b = tid >> 6; float s = 0.f;
#pragma unroll
            for (int w8 = 0; w8 < 8; ++w8) s += red[(w8 * 4 + b) * 64 + lane];
            C.ada()[(size_t)(l * 4 + b) * 6144 + n] = s + C.in(3)[(size_t)l * 6144 + n]; }
        __syncthreads();
    }
    for (int i = blockIdx.x * 512 + tid; i < 4096 * 16; i += gridDim.x * 512) { const float ang = (float)(i >> 4) * INV_FREQ[i & 15]; float s, c; sincos_rr(ang, s, c); C.cosT()[i] = c; C.sinT()[i] = s; }
}
__device__ __forceinline__ void mod_x0(const Ctx& C) {
    const float* x = C.in(0);
    for (size_t i = (size_t)blockIdx.x * 512 + threadIdx.x; i < (size_t)MTOK * DM / 4; i += (size_t)gridDim.x * 512) {
        const size_t e = i * 4; const int row = (int)(e >> 10), col = (int)(e & 1023), b = row >> 12;
        const f32x4 xv = *(const f32x4*)(x + e), sh = *(const f32x4*)(C.ada() + b * 6144 + col), sc = *(const f32x4*)(C.ada() + b * 6144 + 1024 + col);
        const f32x4 h = xv * (sc + 1.0f) + sh; u32x2 w; w.x = cvt_pk_bf16(h[0], h[1]); w.y = cvt_pk_bf16(h[2], h[3]); *(u32x2*)(C.hb() + e) = w;
    }
}
__device__ __forceinline__ void ln_pass(const float* pre, const float* g, const float* bta, float* xout, bf16_t* hb, const float* sh, const float* sc) {
    const int lane = threadIdx.x & 63, wid = threadIdx.x >> 6;
    for (int row = blockIdx.x * 8 + wid; row < MTOK; row += gridDim.x * 8) {
        const float* p = pre + (size_t)row * DM; f32x4 v[4]; float s = 0.f;
#pragma unroll
        for (int i = 0; i < 4; ++i) { v[i] = *(const f32x4*)(p + i * 256 + lane * 4); s += (v[i][0] + v[i][1]) + (v[i][2] + v[i][3]); }
        const float mean = wave_sum(s) * (1.0f / 1024.0f); float q = 0.f;
#pragma unroll
        for (int i = 0; i < 4; ++i) { const f32x4 d = v[i] - mean; q += (d[0] * d[0] + d[1] * d[1]) + (d[2] * d[2] + d[3] * d[3]); }
        const float rstd = rsqrtf(wave_sum(q) * (1.0f / 1024.0f) + 1e-5f); const int b = row >> 12;
#pragma unroll
        for (int i = 0; i < 4; ++i) { const int col = i * 256 + lane * 4; const f32x4 xn = (v[i] - mean) * rstd * *(const f32x4*)(g + col) + *(const f32x4*)(bta + col);
            *(f32x4*)(xout + (size_t)row * DM + col) = xn;
            if (hb) { const f32x4 h = xn * (*(const f32x4*)(sc + b * 6144 + col) + 1.0f) + *(const f32x4*)(sh + b * 6144 + col); u32x2 w; w.x = cvt_pk_bf16(h[0], h[1]); w.y = cvt_pk_bf16(h[2], h[3]); *(u32x2*)(hb + (size_t)row * DM + col) = w; } }
    }
}
__device__ __forceinline__ void token_prepass(const Ctx& C) {
    const int lane = threadIdx.x & 63, wid = threadIdx.x >> 6;
    for (int row = blockIdx.x * 8 + wid; row < MTOK; row += gridDim.x * 8) {
        const bf16_t* pr = C.proj() + (size_t)row * INP;
        float ss = 0.f;
        if (lane < 48) { f32x4 a, b; unpack8(*(const u32x4*)(pr + O_CQ + lane * 8), a, b); ss = (a[0] * a[0] + a[1] * a[1]) + (a[2] * a[2] + a[3] * a[3]) + (b[0] * b[0] + b[1] * b[1]) + (b[2] * b[2] + b[3] * b[3]); }
        const float rq = rsqrtf(wave_sum(ss) * (1.0f / 384.0f) + 1e-6f);
        ss = 0.f;
        if (lane < 32) { f32x4 a, b; unpack8(*(const u32x4*)(pr + O_CKV + lane * 8), a, b); ss = (a[0] * a[0] + a[1] * a[1]) + (a[2] * a[2] + a[3] * a[3]) + (b[0] * b[0] + b[1] * b[1]) + (b[2] * b[2] + b[3] * b[3]); }
        const float rkv = rsqrtf(wave_sum(ss) * (1.0f / 256.0f) + 1e-6f);
        f32x4 a, b; unpack8(*(const u32x4*)(pr + O_VSGU + lane * 8), a, b);
#pragma unroll
        for (int j = 0; j < 4; ++j) { a[j] = geluf_(a[j]); b[j] = geluf_(b[j]); }
        const float mean = wave_sum((a[0] + a[1]) + (a[2] + a[3]) + (b[0] + b[1]) + (b[2] + b[3])) * (1.0f / 512.0f);
        a = a - mean; b = b - mean;
        const float var = wave_sum((a[0] * a[0] + a[1] * a[1]) + (a[2] * a[2] + a[3] * a[3]) + (b[0] * b[0] + b[1] * b[1]) + (b[2] * b[2] + b[3] * b[3])) * (1.0f / 512.0f);
        if (lane == 0) { C.rstd_q()[row] = rq; C.rstd_kv()[row] = rkv; C.sgu_mean()[row] = mean; C.sgu_rstd()[row] = rsqrtf(var + 1e-5f); }
        if (lane < 16) { const float x1 = bf2f(pr[O_KPE + lane]), x2 = bf2f(pr[O_KPE + 16 + lane]); const int pos = row & (SEQ - 1); const float cs = C.cosT()[pos * 16 + lane], sn = C.sinT()[pos * 16 + lane];
            const bf16_t o1 = f2bf(x1 * cs - x2 * sn), o2 = f2bf(x2 * cs + x1 * sn); bf16_t* kp = C.kf() + (size_t)row * QW + 64 + lane;
#pragma unroll
            for (int h = 0; h < 8; ++h) { kp[h * 96] = o1; kp[h * 96 + 16] = o2; } }
    }
}
__device__ __forceinline__ void sgu_phase(const Ctx& C, int l, LAS unsigned char* lds) {
    int tid = threadIdx.x; asm volatile("" : "+v"(tid));
    const int lane = tid & 63, wid = tid >> 6, fr = lane & 15, fq = lane >> 4;
    const float* ln_g = C.in(20) + l * 512; const float* ln_b = C.in(21) + l * 512; const float* b_s = C.in(23) + l * 512;
    for (int u = blockIdx.x; u < 512; u += gridDim.x) {
        const int n = u >> 2, g = u & 3, r0 = n * 128, c0 = g * 128;
#pragma unroll
        for (int i = 0; i < 4; ++i) { const int p = tid + 512 * i, j = p & 127, cp = p >> 7; const size_t row = r0 + j;
            f32x4 a, b; unpack8(*(const u32x4*)(C.proj() + row * INP + O_VSGU + c0 + cp * 8), a, b);
            const float mean = C.sgu_mean()[row], rstd = C.sgu_rstd()[row]; const f32x4 g0 = *(const f32x4*)(ln_g + c0 + cp * 8), g1 = *(const f32x4*)(ln_g + c0 + cp * 8 + 4), b0 = *(const f32x4*)(ln_b + c0 + cp * 8), b1 = *(const f32x4*)(ln_b + c0 + cp * 8 + 4);
#pragma unroll
            for (int e = 0; e < 4; ++e) { *(LAS bf16_t*)(lds + (cp * 8 + e) * 272 + j * 2) = f2bf((geluf_(a[e]) - mean) * rstd * g0[e] + b0[e]);
                                          *(LAS bf16_t*)(lds + (cp * 8 + 4 + e) * 272 + j * 2) = f2bf((geluf_(b[e]) - mean) * rstd * g1[e] + b1[e]); } }
        __syncthreads();
        bf16x8 af[4];
#pragma unroll
        for (int ks = 0; ks < 4; ++ks) af[ks] = *(const bf16x8*)(C.sguw() + (size_t)(g * 128 + 16 * wid + fr) * 128 + ks * 32 + fq * 8);
#pragma unroll
        for (int nt = 0; nt < 8; ++nt) { f32x4 acc = {0.f, 0.f, 0.f, 0.f};
#pragma unroll
            for (int ks = 0; ks < 4; ++ks) { const bf16x8 bfr = *(const LAS bf16x8*)(lds + (nt * 16 + fr) * 272 + (ks * 32 + fq * 8) * 2); acc = __builtin_amdgcn_mfma_f32_16x16x32_bf16(af[ks], bfr, acc, 0, 0, 0); }
#pragma unroll
            for (int r = 0; r < 4; ++r) { const int i = 16 * wid + 4 * fq + r; bf16_t* pu = C.proj() + (size_t)(r0 + i) * INP + O_USGU + c0 + nt * 16 + fr;
                *pu = f2bf(geluf_(bf2f(*pu)) * (acc[r] + b_s[g * 128 + i])); } }
        __syncthreads();
    }
}
template <bool FINAL> __device__ __forceinline__ void s5_phase(const Ctx& C, int l, LAS unsigned char* lds) {
    int tid = threadIdx.x; asm volatile("" : "+v"(tid));
    const int lane = tid & 63, wid = __builtin_amdgcn_readfirstlane(tid >> 6), r32 = lane & 31, hi = lane >> 5, fr = lane & 15, fq = lane >> 4;
    LAS unsigned char* wl = lds + wid * 16896;
    const float* dvec = C.in(13) + l * 512;
    for (int wu = blockIdx.x * 8 + wid; wu < 8192; wu += gridDim.x * 8) {
        const int m = wu >> 5, g = wu & 31, p = lane;
        const float are = C.s5a()[(g * 64 + p) * 2], aim = C.s5a()[(g * 64 + p) * 2 + 1];
        float hre = 0.f, him = 0.f;
        if (FINAL) { const int k = m & 63, mb = m - k; const float a64r = C.s5a64()[(g * 64 + p) * 2], a64i = C.s5a64()[(g * 64 + p) * 2 + 1];
            for (int j = 0; j < k; ++j) { const float* e = C.ebuf() + ((size_t)(mb + j) * 32 + g) * 128 + p; const float er = e[0], ei = e[64];
                const float nr = a64r * hre - a64i * him + er, ni = a64r * him + a64i * hre + ei; hre = nr; him = ni; } }
        bf16x8 bfr[4];
#pragma unroll
        for (int pt = 0; pt < 4; ++pt) bfr[pt] = *(const bf16x8*)(C.s5bb() + (size_t)(g * 128 + pt * 32 + r32) * 16 + hi * 8);
        for (int half = 0; half < 2; ++half) {
            const int t0 = m * 64 + half * 32;
            const bf16x8 afr = *(const bf16x8*)(C.proj() + (size_t)(t0 + r32) * INP + O_US5 + g * 16 + hi * 8);
#pragma unroll
            for (int pt = 0; pt < 4; ++pt) { f32x16 d = {}; d = __builtin_amdgcn_mfma_f32_32x32x16_bf16(afr, bfr[pt], d, 0, 0, 0);
#pragma unroll
                for (int r = 0; r < 16; ++r) { const int t = 8 * (r >> 2) + 4 * hi + (r & 3); *(LAS float*)(wl + t * 528 + (pt * 32 + r32) * 4) = d[r]; } }
            asm volatile("s_waitcnt lgkmcnt(0)" ::: "memory");
#pragma unroll
            for (int t = 0; t < 32; ++t) { const float br = *(const LAS float*)(wl + t * 528 + p * 4), bi = *(const LAS float*)(wl + t * 528 + 256 + p * 4);
                const float nr = are * hre - aim * him + br, ni = are * him + aim * hre + bi; hre = nr; him = ni;
                if (FINAL) { *(LAS bf16_t*)(wl + t * 528 + p * 2) = f2bf(nr); *(LAS bf16_t*)(wl + t * 528 + 128 + p * 2) = f2bf(ni); } }
            if (FINAL) {
                asm volatile("s_waitcnt lgkmcnt(0)" ::: "memory");
#pragma unroll
                for (int tt = 0; tt < 2; ++tt) { f32x4 acc = {0.f, 0.f, 0.f, 0.f};
#pragma unroll
                    for (int ks = 0; ks < 4; ++ks) { const bf16x8 a = *(const LAS bf16x8*)(wl + (tt * 16 + fr) * 528 + (ks * 32 + fq * 8) * 2);
                        const bf16x8 b = *(const bf16x8*)(C.s5cm() + (size_t)(g * 16 + fr) * 128 + ks * 32 + fq * 8); acc = __builtin_amdgcn_mfma_f32_16x16x32_bf16(a, b, acc, 0, 0, 0); }
                    const int c = g * 16 + fr; const float dd = dvec[c];
#pragma unroll
                    for (int r = 0; r < 4; ++r) { const size_t tok = (size_t)(t0 + tt * 16 + 4 * fq + r); const float uu = bf2f(C.proj()[tok * INP + O_US5 + c]);
                        C.zb()[tok * 512 + c] = f2bf(geluf_(acc[r] + dd * uu)); } }
                asm volatile("s_waitcnt lgkmcnt(0)" ::: "memory");
            }
        }
        if (!FINAL) { float* e = C.ebuf() + ((size_t)m * 32 + g) * 128 + p; e[0] = hre; e[64] = him; }
    }
}
__device__ __forceinline__ void attn_unit(const Ctx& C, int b, int h, int qb, LAS unsigned char* lds, bool dummy = false) {
    int tid = threadIdx.x; asm volatile("" : "+v"(tid));
    const int lane = tid & 63, wid = __builtin_amdgcn_readfirstlane(tid >> 6), r32 = lane & 31, hi = lane >> 5;
    const int NT = 4 * qb + 4, cw = 4 * qb + (wid >> 1);
    const size_t qrow = (size_t)b * SEQ + 256 * qb + 32 * wid + r32;
    bf16x8 qf[6];
#pragma unroll
    for (int ds = 0; ds < 4; ++ds) qf[ds] = *(const bf16x8*)(C.qb() + qrow * QW + h * 64 + ds * 16 + hi * 8);
    {
      f32x4 a0, a1, b0, b1; unpack8(*(const u32x4*)(C.qb() + qrow * QW + 512 + h * 32 + hi * 8), a0, a1); unpack8(*(const u32x4*)(C.qb() + qrow * QW + 512 + h * 32 + 16 + hi * 8), b0, b1);
      const int pos = (int)(qrow & (SEQ - 1)); const float* cp = C.cosT() + pos * 16 + hi * 8; const float* sp = C.sinT() + pos * 16 + hi * 8;
      const f32x4 c0 = *(const f32x4*)cp, c1 = *(const f32x4*)(cp + 4), s0 = *(const f32x4*)sp, s1 = *(const f32x4*)(sp + 4);
      qf[4] = __builtin_bit_cast(bf16x8, pack8(a0 * c0 - b0 * s0, a1 * c1 - b1 * s1)); qf[5] = __builtin_bit_cast(bf16x8, pack8(b0 * c0 + a0 * s0, b1 * c1 + a1 * s1)); }
    f32x16 o0 = {}, o1 = {}; float mrun = -1e30f, lrun = 0.f;
    const bf16_t* kbase = C.kf() + (size_t)b * SEQ * QW + h * 96;
    const bf16_t* vbase = C.vt() + (size_t)b * SEQ * 512 + h * 64;
    const int kk0 = tid / 12, pc0 = tid % 12, p1 = 512 + tid, kk1 = p1 / 12, pc1 = p1 % 12; const bool has1 = tid < 256;
    u32x4 kr0, kr1 = {0u, 0u, 0u, 0u}, vr;
#define ATT_LOAD(t) do { kr0 = *(const u32x4*)(kbase + (size_t)((t) * 64 + kk0) * QW + pc0 * 8); if (has1) kr1 = *(const u32x4*)(kbase + (size_t)((t) * 64 + kk1) * QW + pc1 * 8); \
        vr = *(const u32x4*)(vbase + (size_t)((t) * 64 + lane) * 512 + wid * 8); } while (0)
#define ATT_STORE(bf) do { LAS unsigned char* bb_ = lds + (bf) * 22016; *(LAS u32x4*)(bb_ + kk0 * 208 + pc0 * 16) = kr0; if (has1) *(LAS u32x4*)(bb_ + kk1 * 208 + pc1 * 16) = kr1; \
        LAS unsigned char* vv_ = bb_ + 13312 + (wid * 8) * 136 + lane * 2; \
        *(LAS bf16_t*)(vv_) = (bf16_t)vr.x; *(LAS bf16_t*)(vv_ + 136) = (bf16_t)(vr.x >> 16); *(LAS bf16_t*)(vv_ + 2 * 136) = (bf16_t)vr.y; *(LAS bf16_t*)(vv_ + 3 * 136) = (bf16_t)(vr.y >> 16); \
        *(LAS bf16_t*)(vv_ + 4 * 136) = (bf16_t)vr.z; *(LAS bf16_t*)(vv_ + 5 * 136) = (bf16_t)(vr.z >> 16); *(LAS bf16_t*)(vv_ + 6 * 136) = (bf16_t)vr.w; *(LAS bf16_t*)(vv_ + 7 * 136) = (bf16_t)(vr.w >> 16); } while (0)
    ATT_LOAD(0); ATT_STORE(0); __syncthreads();
    for (int t = 0; t < NT; ++t) {
        if (t + 1 < NT) ATT_LOAD(t + 1);
        if (t <= cw) {
            const LAS unsigned char* kb = lds + (t & 1) * 22016; const LAS unsigned char* vb = kb + 13312;
            f32x16 p0 = {}, p1v = {};
#pragma unroll
            for (int ds = 0; ds < 6; ++ds) { const bf16x8 a0 = *(const LAS bf16x8*)(kb + r32 * 208 + (ds * 16 + hi * 8) * 2), a1 = *(const LAS bf16x8*)(kb + (32 + r32) * 208 + (ds * 16 + hi * 8) * 2);
                p0 = __builtin_amdgcn_mfma_f32_32x32x16_bf16(a0, qf[ds], p0, 0, 0, 0); p1v = __builtin_amdgcn_mfma_f32_32x32x16_bf16(a1, qf[ds], p1v, 0, 0, 0); }
            float mx = fmaxf(p0[0], p1v[0]);
#pragma unroll
            for (int r = 1; r < 16; ++r) mx = fmaxf(mx, fmaxf(p0[r], p1v[r]));
            mx = fmaxf(mx, __shfl_xor(mx, 32));
            const float mn = fmaxf(mrun, mx), alpha = fexp2(mrun - mn); mrun = mn;
            float rs = 0.f;
#pragma unroll
            for (int r = 0; r < 16; ++r) { p0[r] = fexp2(p0[r] - mn); p1v[r] = fexp2(p1v[r] - mn); rs += p0[r] + p1v[r]; }
            lrun = lrun * alpha + rs;
#pragma unroll
            for (int r = 0; r < 16; ++r) { o0[r] *= alpha; o1[r] *= alpha; }
            bf16x8 pf[4];
            { u32x4 w;
              w.x = cvt_pk_bf16(p0[0], p0[1]); w.y = cvt_pk_bf16(p0[2], p0[3]); w.z = cvt_pk_bf16(p0[4], p0[5]); w.w = cvt_pk_bf16(p0[6], p0[7]); pf[0] = __builtin_bit_cast(bf16x8, w);
              w.x = cvt_pk_bf16(p0[8], p0[9]); w.y = cvt_pk_bf16(p0[10], p0[11]); w.z = cvt_pk_bf16(p0[12], p0[13]); w.w = cvt_pk_bf16(p0[14], p0[15]); pf[1] = __builtin_bit_cast(bf16x8, w);
              w.x = cvt_pk_bf16(p1v[0], p1v[1]); w.y = cvt_pk_bf16(p1v[2], p1v[3]); w.z = cvt_pk_bf16(p1v[4], p1v[5]); w.w = cvt_pk_bf16(p1v[6], p1v[7]); pf[2] = __builtin_bit_cast(bf16x8, w);
              w.x = cvt_pk_bf16(p1v[8], p1v[9]); w.y = cvt_pk_bf16(p1v[10], p1v[11]); w.z = cvt_pk_bf16(p1v[12], p1v[13]); w.w = cvt_pk_bf16(p1v[14], p1v[15]); pf[3] = __builtin_bit_cast(bf16x8, w); }
#pragma unroll
            for (int ks = 0; ks < 4; ++ks) {
                { const u32x2 lo = *(const LAS u32x2*)(vb + r32 * 136 + (16 * ks + 4 * hi) * 2), hh = *(const LAS u32x2*)(vb + r32 * 136 + (16 * ks + 8 + 4 * hi) * 2);
                  const u32x4 w = {lo.x, lo.y, hh.x, hh.y}; o0 = __builtin_amdgcn_mfma_f32_32x32x16_bf16(__builtin_bit_cast(bf16x8, w), pf[ks], o0, 0, 0, 0); }
                { const u32x2 lo = *(const LAS u32x2*)(vb + (32 + r32) * 136 + (16 * ks + 4 * hi) * 2), hh = *(const LAS u32x2*)(vb + (32 + r32) * 136 + (16 * ks + 8 + 4 * hi) * 2);
                  const u32x4 w = {lo.x, lo.y, hh.x, hh.y}; o1 = __builtin_amdgcn_mfma_f32_32x32x16_bf16(__builtin_bit_cast(bf16x8, w), pf[ks], o1, 0, 0, 0); }
            }
        }
        if (t + 1 < NT) ATT_STORE((t + 1) & 1);
        __syncthreads();
    }
#undef ATT_LOAD
#undef ATT_STORE
    const float linv = 1.0f / (lrun + __shfl_xor(lrun, 32));
    bf16_t* op = C.qb() + qrow * QW + h * 64 + 4 * hi;
    if (dummy && linv != 123.456f) return;
#pragma unroll
    for (int g4 = 0; g4 < 4; ++g4) {
        u32x2 w; w.x = cvt_pk_bf16(o0[4 * g4] * linv, o0[4 * g4 + 1] * linv); w.y = cvt_pk_bf16(o0[4 * g4 + 2] * linv, o0[4 * g4 + 3] * linv); *(u32x2*)(op + 8 * g4) = w;
        w.x = cvt_pk_bf16(o1[4 * g4] * linv, o1[4 * g4 + 1] * linv); w.y = cvt_pk_bf16(o1[4 * g4 + 2] * linv, o1[4 * g4 + 3] * linv); *(u32x2*)(op + 32 + 8 * g4) = w;
    }
}
__device__ __forceinline__ void attn_phase(const Ctx& C, LAS unsigned char* lds) {
    for (int pi = blockIdx.x; pi < 256; pi += gridDim.x) {
        const int xcd = pi & 7, k = pi >> 3, bh = xcd * 4 + (k >> 3), j = k & 7, b = bh >> 3, h = bh & 7;
        if ((PROBE_MASK >> 1) & 1) { attn_unit(C, b, h, 15 - j, lds, true); attn_unit(C, b, h, j, lds, true); }
        attn_unit(C, b, h, 15 - j, lds);
        attn_unit(C, b, h, j, lds);
    }
}

__global__ void __launch_bounds__(512, 2) fwd_megakernel(Params P) {
    extern __shared__ __attribute__((aligned(16))) unsigned char lds_raw[];
    LAS unsigned char* lds = (LAS unsigned char*)lds_raw;
    cg::grid_group grid = cg::this_grid();
    if (threadIdx.x < 4) ((LAS unsigned*)(lds + LDS_PHASE))[threadIdx.x] = 0u;
    __syncthreads();
    (void)xcd_barrier_post((unsigned*)(mk_ctx().wsb() + WS_BAR), (volatile LAS unsigned*)(lds + LDS_PHASE));
#define GSYNC() do { XcdBarrier xb_; xb_.bar = (unsigned*)(mk_ctx().wsb() + WS_BAR); xb_.x = xb_xcc_id(); xb_.st = (volatile LAS unsigned*)(lds + LDS_PHASE); xcd_barrier(xb_); } while (0)
    const int G = gridDim.x, cid = blockIdx.x;

    { NEWCTX;
#if !defined(NO_CONV)
      convert_layer(C, 0, lds);
#endif
    }
    { NEWCTX;
#if !defined(NO_ADA)
      ada_tables(C, lds);
#endif
    }
    grid.sync();
    { NEWCTX; mod_x0(C); }
    GSYNC();

#pragma unroll 1
    for (int l = 0; l < DEPTH; ++l) {
        pg8::StaticOrder S;
        { NEWCTX; pg8::Gemm g{C.hb(), C.w_in(), MTOK, INP, 1024, 1024}; S.init(MTOK, INP, G, cid); EpiProj E{C.proj(), C.b_inp()}; REP(0) pg8::gemm_phase(lds, g, S, E); }
        GSYNC();
        { NEWCTX;
#if !defined(NO_PRE)
          REP(3) token_prepass(C);
#endif
        }
        GSYNC();
        { NEWCTX; pg8::Gemm g{C.proj() + O_CQ, C.w_q(), MTOK, 768, 384, INP}; S.init(MTOK, 768, G, cid); EpiQ E{C.qb(), C.rstd_q()}; REP(0) pg8::gemm_phase(lds, g, S, E); }
        { NEWCTX; pg8::Gemm g{C.proj() + O_CKV, C.w_kv(), MTOK, 1024, 256, INP}; S.init(MTOK, 1024, G, cid); EpiKV E{C.kf(), C.vt(), C.rstd_kv()}; REP(0) pg8::gemm_phase(lds, g, S, E); }
        __syncthreads();
        { NEWCTX;
#if !defined(NO_SGU)
          sgu_phase(C, l, lds);
#endif
        }
        { NEWCTX;
#if !defined(NO_S5)
          REP(2) s5_phase<false>(C, l, lds);
#endif
        }
        GSYNC();
        { NEWCTX;
#if !defined(NO_ATT)
          attn_phase(C, lds);
#endif
        }
        __syncthreads();
        { NEWCTX;
#if !defined(NO_S5)
          REP(2) s5_phase<true>(C, l, lds);
#endif
        }
        GSYNC();
        { NEWCTX; pg8::Gemm g{C.zb(), C.w_glu(), MTOK, 512, 512, 512}; S.init(MTOK, 512, G, cid); EpiGlu E{C.zb(), C.proj(), C.in(15) + l * 512}; REP(0) pg8::gemm_phase(lds, g, S, E); }
        GSYNC();
        S.init(MTOK, 1024, G, cid);
        { NEWCTX; pg8::Gemm g{C.proj() + O_US5, C.w_br(), MTOK, 1024, 512, INP}; EpiBranch<0> E{C.proj() + O_GATE, C.pre(), C.merged()}; REP(0) pg8::gemm_phase(lds, g, S, E); }
        { NEWCTX; pg8::Gemm g{C.qb(), C.w_br() + (size_t)1024 * 512, MTOK, 1024, 512, QW}; EpiBranch<1> E{C.proj() + O_GATE + 1024, C.pre(), C.merged()}; REP(0) pg8::gemm_phase(lds, g, S, E); }
        { NEWCTX; pg8::Gemm g{C.proj() + O_USGU, C.w_br() + (size_t)2 * 1024 * 512, MTOK, 1024, 512, INP}; EpiBranch<2> E{C.proj() + O_GATE + 2048, C.pre(), C.merged()}; REP(0) pg8::gemm_phase(lds, g, S, E); }
        GSYNC();
        { NEWCTX; const float* xres = (l == 0) ? C.in(0) : C.xcur();
          pg8::Gemm g{C.merged(), C.w_out(), MTOK, 1024, 1024, 1024}; EpiRes E{xres, C.pre(), C.ada() + (size_t)l * 4 * 6144 + 2048}; REP(0) pg8::gemm_phase(lds, g, S, E); }
        GSYNC();
        { NEWCTX; const float* ada_l = C.ada() + (size_t)l * 4 * 6144; REP(3) ln_pass(C.pre(), C.in(26) + l * 1024, C.in(27) + l * 1024, C.xcur(), C.hb(), ada_l + 3072, ada_l + 4096); }
        GSYNC();
        { NEWCTX; pg8::Gemm g{C.hb(), C.w_f1(), MTOK, FF2, 1024, 1024}; pg8::StaticOrder S2; S2.init(MTOK, FF2, G, cid); EpiFfn1 E{C.hid()}; REP(0) pg8::gemm_phase(lds, g, S2, E); }
        GSYNC();
        { NEWCTX; pg8::Gemm g{C.hid(), C.w_f2(), MTOK, 1024, FF, FF}; EpiRes E{C.xcur(), C.pre(), C.ada() + (size_t)l * 4 * 6144 + 5120}; REP(0) pg8::gemm_phase(lds, g, S, E); }
        GSYNC();
        if (l + 1 < DEPTH) {
            { NEWCTX; const float* ada_n = C.ada() + (size_t)(l + 1) * 4 * 6144; REP(3) ln_pass(C.pre(), C.in(30) + l * 1024, C.in(31) + l * 1024, C.xcur(), C.hb(), ada_n, ada_n + 1024); }
            __syncthreads();
            { NEWCTX;
#if !defined(NO_CONV)
              REP(4) convert_layer(C, l + 1, lds);
#endif
            }
        } else { NEWCTX; ln_pass(C.pre(), C.in(30) + l * 1024, C.in(31) + l * 1024, C.out(), nullptr, nullptr, nullptr); }
        GSYNC();
    }
}

extern "C" void kernel_launch(void* const* d_in, const int* in_sizes, int n_in, void* d_out, int out_size, void* d_ws, size_t ws_size, hipStream_t stream) {
    static int grid_blocks = 0;
    if (grid_blocks == 0) {
        if (n_in != 32 || out_size != MTOK * DM || ws_size < WS_END) { fprintf(stderr, "kernel_launch: unexpected problem (n_in %d out %d ws %zu need %zu)\n", n_in, out_size, ws_size, (size_t)WS_END); grid_blocks = -1; return; }
        int dev = 0, cus = 0, per_cu = 0;
        hipGetDevice(&dev);
        hipDeviceGetAttribute(&cus, hipDeviceAttributeMultiprocessorCount, dev);
        hipFuncSetAttribute((const void*)fwd_megakernel, hipFuncAttributeMaxDynamicSharedMemorySize, LDS_BYTES);
        hipOccupancyMaxActiveBlocksPerMultiprocessor(&per_cu, (const void*)fwd_megakernel, 512, LDS_BYTES);
        if (per_cu < 1) per_cu = 1;
        grid_blocks = cus * per_cu;
        (void)hipGetLastError();
    }
    if (grid_blocks < 0) return;
    (void)hipMemsetAsync((unsigned char*)d_ws + WS_BAR, 0, 16384, stream);
    Params p{};
    for (int i = 0; i < 32; ++i) p.in[i] = (const float*)d_in[i];
    p.out = (float*)d_out; p.ws = (unsigned char*)d_ws;
    void* args[] = {&p};
    hipError_t e = hipLaunchCooperativeKernel((const void*)fwd_megakernel, dim3(grid_blocks), dim3(512), args, LDS_BYTES, stream);
    if (e != hipSuccess) fprintf(stderr, "cooperative launch failed: %s (grid %d)\n", hipGetErrorString(e), grid_blocks);
}
```

```cpp
#include <hip/hip_runtime.h>
#include <hip/hip_cooperative_groups.h>
#include <cstdint>
#include <cstdio>
namespace cg = cooperative_groups;

#define LAS __attribute__((address_space(3)))
typedef unsigned short bf16_t;
typedef short bf16x8 __attribute__((ext_vector_type(8)));
typedef float f32x4 __attribute__((ext_vector_type(4)));
typedef float f32x16 __attribute__((ext_vector_type(16)));
typedef unsigned u32x4 __attribute__((ext_vector_type(4)));
typedef unsigned u32x2 __attribute__((ext_vector_type(2)));

constexpr int SEQ = 4096, MTOK = 16384, DM = 1024, DEPTH = 4;
constexpr int INW = 5280, INP = 5376;
constexpr int O_US5 = 0, O_CQ = 512, O_CKV = 896, O_KPE = 1152, O_USGU = 1184, O_VSGU = 1696, O_GATE = 2208;
constexpr int FF = 2816, FF2 = 5632, QW = 768;
constexpr float ALPHA = 1.681792830507429f;
constexpr float QSCALE = 0.14724444602590306f;
constexpr int LDS_PHASE = 135168;
constexpr int LDS_BYTES = LDS_PHASE + 16;

constexpr size_t al256(size_t x) { return (x + 255) & ~(size_t)255; }
constexpr size_t WS_W_IN = 0;
constexpr size_t WS_W_Q = WS_W_IN + (size_t)INP * 1024 * 2;
constexpr size_t WS_W_KV = WS_W_Q + (size_t)768 * 384 * 2;
constexpr size_t WS_W_GLU = WS_W_KV + (size_t)1024 * 256 * 2;
constexpr size_t WS_W_BR = WS_W_GLU + (size_t)512 * 512 * 2;
constexpr size_t WS_W_OUT = WS_W_BR + (size_t)3 * 1024 * 512 * 2;
constexpr size_t WS_W_F1 = WS_W_OUT + (size_t)1024 * 1024 * 2;
constexpr size_t WS_W_F2 = WS_W_F1 + (size_t)FF2 * 1024 * 2;
constexpr size_t WS_B_INP = WS_W_F2 + (size_t)1024 * FF * 2;
constexpr size_t WS_SGUW = WS_B_INP + (size_t)INP * 4;
constexpr size_t WS_S5BB = WS_SGUW + (size_t)4 * 128 * 128 * 2;
constexpr size_t WS_S5CM = WS_S5BB + (size_t)32 * 128 * 16 * 2;
constexpr size_t WS_S5A = WS_S5CM + (size_t)32 * 16 * 128 * 2;
constexpr size_t WS_S5A64 = WS_S5A + (size_t)32 * 64 * 2 * 4;
constexpr size_t WS_ADA = al256(WS_S5A64 + (size_t)32 * 64 * 2 * 4);
constexpr size_t WS_COS = WS_ADA + (size_t)4 * 4 * 6144 * 4;
constexpr size_t WS_SIN = WS_COS + (size_t)4096 * 16 * 4;
constexpr size_t WS_STAT = WS_SIN + (size_t)4096 * 16 * 4;
constexpr size_t WS_EBUF = WS_STAT + (size_t)4 * 16384 * 4;
constexpr size_t WS_PROJ = al256(WS_EBUF + (size_t)256 * 32 * 128 * 4);
constexpr size_t WS_XCUR = WS_PROJ + (size_t)MTOK * INP * 2;
constexpr size_t WS_PRE = WS_XCUR + (size_t)MTOK * DM * 4;
constexpr size_t WS_KF = WS_PRE;
constexpr size_t WS_VT = WS_KF + (size_t)MTOK * QW * 2;
constexpr size_t WS_Z = WS_VT + (size_t)2048 * 4096 * 2;
constexpr size_t WS_HB = WS_PRE + (size_t)MTOK * DM * 4;
constexpr size_t WS_QB = WS_HB + (size_t)MTOK * DM * 2;
constexpr size_t WS_BAR = WS_QB + (size_t)MTOK * QW * 2;
constexpr size_t WS_END = WS_BAR + 16384;
static_assert(WS_Z + (size_t)MTOK * 512 * 2 <= WS_HB, "overlay");

#ifndef PROBE_MASK
#define PROBE_MASK 0
#endif
#define REP(bit) for (int rep_ = 0; rep_ < (((PROBE_MASK) >> (bit)) & 1) + 1; ++rep_)
__device__ __forceinline__ unsigned cvt_pk_bf16(float lo, float hi) { unsigned r; asm volatile("v_cvt_pk_bf16_f32 %0, %1, %2" : "=v"(r) : "v"(lo), "v"(hi)); return r; }
__device__ __forceinline__ bf16_t f2bf(float x) { return (bf16_t)(cvt_pk_bf16(x, 0.f) & 0xffffu); }
__device__ __forceinline__ float bf2f(bf16_t v) { return __uint_as_float((unsigned)v << 16); }
__device__ __forceinline__ float bflo(unsigned w) { return __uint_as_float(w << 16); }
__device__ __forceinline__ float bfhi(unsigned w) { return __uint_as_float(w & 0xffff0000u); }
__device__ __forceinline__ float fexp2(float x) { return __builtin_amdgcn_exp2f(x); }
__device__ __forceinline__ float frcp(float x) { return __builtin_amdgcn_rcpf(x); }
__device__ __forceinline__ float sigmoidf_(float x) { return frcp(1.0f + fexp2(-1.4426950408889634f * x)); }
__device__ __forceinline__ float siluf_(float x) { return x * sigmoidf_(x); }
__device__ __forceinline__ float geluf_(float x) { const float u = 1.5957691216057308f * (x + 0.044715f * x * x * x); return x * sigmoidf_(u); }
__device__ __forceinline__ float wave_sum(float v) {
#pragma unroll
    for (int o = 32; o > 0; o >>= 1) v += __shfl_xor(v, o);
    return v;
}
__device__ __forceinline__ void sincos_rr(float x, float& s, float& c) {
    const float k = rintf(x * 0.15915494309189535f);
    float r = fmaf(-k, 6.2831854820251465f, x);
    r = fmaf(-k, -1.7484555e-07f, r);
    s = sinf(r); c = cosf(r);
}
__device__ const float INV_FREQ[16] = {1.000000000e+00f, 5.623413324e-01f, 3.162277639e-01f, 1.778279394e-01f, 1.000000015e-01f, 5.623412877e-02f, 3.162277862e-02f, 1.778279431e-02f,
                                       9.999999776e-03f, 5.623413250e-03f, 3.162277862e-03f, 1.778279431e-03f, 1.000000047e-03f, 5.623413017e-04f, 3.162277862e-04f, 1.778279402e-04f};

namespace pg8 {
constexpr int BM = 256, BK = 64, HALF = 128, HTB = HALF * BK * 2, STAGE_BYTES = 8 * HTB, NXCD = 8, WGM = 8;
__device__ __forceinline__ int lds_byte(int r, int c) { const int st = (r >> 4) * 2 + (c >> 5), rr = r & 15, cc = c & 31, ob = rr * 64 + cc * 2; return st * 1024 + (ob ^ (((ob >> 9) & 1) << 5)); }
__device__ __forceinline__ void stage_rc(int b, int& R, int& C) { const int st = b / 1024, sb = b % 1024, swz = sb ^ (((sb >> 9) & 1) << 5); R = (st >> 1) * 16 + swz / 64; C = (st & 1) * 32 + (swz % 64) / 2; }
__device__ __forceinline__ int perm32(int rho) { const int n = rho >> 4, i = rho & 15; return 8 * (i >> 2) + 4 * n + (i & 3); }
struct Unit { int pm, pn; };
struct Gemm { const bf16_t* A; const bf16_t* Bt; int M, N, K, lda; };
struct StaticOrder {
    int nM, nN, nwg, G, c;
    __device__ void init(int M, int N, int G_, int c_) { nM = M / BM; nN = N / BM; nwg = nM * nN; G = G_; c = c_; }
    __device__ bool next(int i, Unit& u) const {
        const long L = (long)i * G + c; if (L >= nwg) return false;
        int wgid = (int)L; { const int q = nwg / NXCD, r = nwg % NXCD, xcd = wgid % NXCD, off = wgid / NXCD; wgid = (xcd < r ? xcd * (q + 1) : r * (q + 1) + (xcd - r) * q) + off; }
        const int nig = WGM * nN, gid = wgid / nig, fm = gid * WGM, gsz = (nM - fm) < WGM ? (nM - fm) : WGM;
        u.pm = fm + ((wgid % nig) % gsz); u.pn = (wgid % nig) / gsz; return true;
    }
};
template <class Epi>
__device__ __forceinline__ void gemm_phase(LAS unsigned char* lds, const Gemm g, const StaticOrder& S, const Epi& E) {
#if defined(NO_GEMM)
    return;
#endif
    int tid = threadIdx.x; asm volatile("" : "+v"(tid));
    const int wid = __builtin_amdgcn_readfirstlane(tid >> 6), lane = tid & 63, wr = wid >> 2, wc = wid & 3, fr = lane & 15, fq = lane >> 4;
    const int K = g.K, nt = K / BK, lda = g.lda;
    unsigned voffA[2], voffB[2];
#pragma unroll
    for (int i = 0; i < 2; ++i) { int R, C; stage_rc(tid * 16 + i * 8192, R, C); const int Rb = Epi::PERM ? ((R & ~31) + perm32(R & 31)) : R;
        voffA[i] = (unsigned)(R * lda + C) * 2u; voffB[i] = (unsigned)(Rb * K + C) * 2u; }
    const size_t kstep = (size_t)(BK * 2);
    const size_t hstepA = (size_t)HALF * lda * 2, hstepB = (size_t)HALF * K * 2;
    const size_t tstepA = 2 * hstepA, tstepB = 2 * hstepB;
    const unsigned ldsw = (unsigned)wid * 1024u;
    const int aoff = lds_byte(wr * 64 + fr, fq * 8), boff = lds_byte(wc * 32 + fr, fq * 8);
#define PG8_SA(b, h) (((b) * 2 + (h)) * HTB)
#define PG8_SB(b, h) ((4 + (b) * 2 + (h)) * HTB)
#define PG8_STAGE(bufoff, gbase, voff) do { _Pragma("unroll") for (int _i = 0; _i < 2; ++_i) \
        __builtin_amdgcn_global_load_lds((const unsigned*)((const char*)(gbase) + (voff)[_i]), (LAS unsigned*)(lds + (bufoff) + ldsw + _i * 8192), 16, 0, 0); } while (0)
#define PG8_LDA(dst, b, h) do { _Pragma("unroll") for (int m = 0; m < 4; ++m) _Pragma("unroll") for (int k = 0; k < 2; ++k) dst[m][k] = *(const LAS bf16x8*)(lds + PG8_SA(b, h) + aoff + m * 2048 + k * 1024); } while (0)
#define PG8_LDB(dst, b, h) do { _Pragma("unroll") for (int n = 0; n < 2; ++n) _Pragma("unroll") for (int k = 0; k < 2; ++k) dst[n][k] = *(const LAS bf16x8*)(lds + PG8_SB(b, h) + boff + n * 2048 + k * 1024); } while (0)
#define PG8_MMA(ai, bj, At, Bt) do { __builtin_amdgcn_s_setprio(1); _Pragma("unroll") for (int m = 0; m < 4; ++m) _Pragma("unroll") for (int n = 0; n < 2; ++n) _Pragma("unroll") for (int k = 0; k < 2; ++k) \
        acc[ai][bj][m][n] = __builtin_amdgcn_mfma_f32_16x16x32_bf16(Bt[n][k], At[m][k], acc[ai][bj][m][n], 0, 0, 0); __builtin_amdgcn_s_setprio(0); } while (0)
#define PG8_WAIT_V(n) asm volatile("s_waitcnt vmcnt(" #n ")" ::: "memory")
#define PG8_WAIT_L(n) asm volatile("s_waitcnt lgkmcnt(" #n ")" ::: "memory")
#define PG8_BAR __builtin_amdgcn_s_barrier()
#define PG8_SCHED __builtin_amdgcn_sched_barrier(0)
    Unit cur, nxt; int ui = 0;
    if (!S.next(0, cur)) return;
    f32x4 acc[2][2][4][2];
#pragma unroll
    for (int a = 0; a < 2; ++a)
#pragma unroll
        for (int b = 0; b < 2; ++b)
#pragma unroll
            for (int m = 0; m < 4; ++m)
#pragma unroll
                for (int n = 0; n < 2; ++n) acc[a][b][m][n] = (f32x4){0.f, 0.f, 0.f, 0.f};
    bf16x8 At[4][2], B0[2][2], B1[2][2];
    const char* cA = (const char*)g.A + (size_t)cur.pm * tstepA; const char* cB = (const char*)g.Bt + (size_t)cur.pn * tstepB;
    PG8_STAGE(PG8_SB(0, 0), cB, voffB); PG8_STAGE(PG8_SB(0, 1), cB + hstepB, voffB); PG8_STAGE(PG8_SA(0, 0), cA, voffA); PG8_STAGE(PG8_SA(0, 1), cA + hstepA, voffA);
    if (wr == 1) PG8_BAR;
    PG8_WAIT_V(2); PG8_BAR;
    PG8_STAGE(PG8_SB(1, 0), cB + kstep, voffB); PG8_STAGE(PG8_SA(1, 0), cA + kstep, voffA); PG8_STAGE(PG8_SB(1, 1), cB + hstepB + kstep, voffB);
    PG8_WAIT_V(6); PG8_BAR;
    for (;;) {
        const bool has_next = S.next(ui + 1, nxt);
        const char* nA = has_next ? (const char*)g.A + (size_t)nxt.pm * tstepA : cA; const char* nB = has_next ? (const char*)g.Bt + (size_t)nxt.pn * tstepB : cB;
#pragma unroll 1
        for (int t = 0; t < nt; t += 2) {
            const bool last = (t == nt - 2);
            const char* a1 = cA + (size_t)(t + 1) * kstep;
            const char* a2 = last ? nA : cA + (size_t)(t + 2) * kstep; const char* b2 = last ? nB : cB + (size_t)(t + 2) * kstep;
            const char* a3 = a2 + kstep; const char* b3 = b2 + kstep;
            PG8_LDB(B0, 0, 0); PG8_LDB(B1, 0, 1); PG8_SCHED; PG8_LDA(At, 0, 0); PG8_STAGE(PG8_SA(1, 1), a1 + hstepA, voffA);
            PG8_WAIT_V(8); PG8_WAIT_L(0); PG8_BAR; PG8_MMA(0, 0, At, B0); PG8_MMA(0, 1, At, B1); PG8_BAR; PG8_SCHED;
            PG8_LDA(At, 0, 1); PG8_STAGE(PG8_SB(0, 0), b2, voffB); PG8_STAGE(PG8_SB(0, 1), b2 + hstepB, voffB); PG8_STAGE(PG8_SA(0, 0), a2, voffA);
            PG8_WAIT_V(8); PG8_WAIT_L(0); PG8_BAR; PG8_MMA(1, 0, At, B0); PG8_MMA(1, 1, At, B1); PG8_BAR; PG8_SCHED;
            PG8_LDB(B0, 1, 0); PG8_LDB(B1, 1, 1); PG8_SCHED; PG8_LDA(At, 1, 0); PG8_STAGE(PG8_SA(0, 1), a2 + hstepA, voffA);
            PG8_WAIT_V(8); PG8_WAIT_L(0); PG8_BAR; PG8_MMA(0, 0, At, B0); PG8_MMA(0, 1, At, B1); PG8_BAR; PG8_SCHED;
            PG8_LDA(At, 1, 1); PG8_STAGE(PG8_SB(1, 0), b3, voffB); PG8_STAGE(PG8_SB(1, 1), b3 + hstepB, voffB); PG8_STAGE(PG8_SA(1, 0), a3, voffA);
            PG8_WAIT_V(8); PG8_WAIT_L(0); PG8_BAR; PG8_MMA(1, 0, At, B0); PG8_MMA(1, 1, At, B1); PG8_BAR; PG8_SCHED;
        }
        if (wr == 0) PG8_BAR;
        E(acc, cur, wr, wc, fr, fq);
        if (!has_next) break;
#pragma unroll
        for (int a = 0; a < 2; ++a)
#pragma unroll
            for (int b = 0; b < 2; ++b)
#pragma unroll
                for (int m = 0; m < 4; ++m)
#pragma unroll
                    for (int n = 0; n < 2; ++n) acc[a][b][m][n] = (f32x4){0.f, 0.f, 0.f, 0.f};
        cur = nxt; cA = nA; cB = nB; ++ui;
        if (wr == 1) PG8_BAR;
    }
    PG8_WAIT_V(0);
    PG8_BAR;
#undef PG8_SA
#undef PG8_SB
#undef PG8_STAGE
#undef PG8_LDA
#undef PG8_LDB
#undef PG8_MMA
#undef PG8_WAIT_V
#undef PG8_WAIT_L
#undef PG8_BAR
#undef PG8_SCHED
}
}
using pg8::Unit;
typedef f32x4 AccT[2][2][4][2];

__device__ __forceinline__ u32x4 pack8(const f32x4 a, const f32x4 b) { u32x4 w; w.x = cvt_pk_bf16(a[0], a[1]); w.y = cvt_pk_bf16(a[2], a[3]); w.z = cvt_pk_bf16(b[0], b[1]); w.w = cvt_pk_bf16(b[2], b[3]); return w; }
__device__ __forceinline__ void unpack8(const u32x4 w, f32x4& a, f32x4& b) { a = (f32x4){bflo(w.x), bfhi(w.x), bflo(w.y), bfhi(w.y)}; b = (f32x4){bflo(w.z), bfhi(w.z), bflo(w.w), bfhi(w.w)}; }

struct EpiProj { static constexpr bool PERM = true;
    bf16_t* O; const float* bias;
    __device__ __forceinline__ void operator()(const AccT& acc, const Unit& u, int wr, int wc, int fr, int fq) const {
        const int row0 = u.pm * 256 + wr * 64 + fr, col0 = u.pn * 256 + wc * 32 + 8 * fq;
#pragma unroll
        for (int bj = 0; bj < 2; ++bj) { const f32x4 b0 = *(const f32x4*)(bias + col0 + bj * 128), b1 = *(const f32x4*)(bias + col0 + bj * 128 + 4);
#pragma unroll
            for (int ai = 0; ai < 2; ++ai)
#pragma unroll
                for (int m = 0; m < 4; ++m) { bf16_t* p = O + (size_t)(row0 + ai * 128 + m * 16) * INP + col0 + bj * 128;
                    *(u32x4*)p = pack8(acc[ai][bj][m][0] + b0, acc[ai][bj][m][1] + b1); } }
    }
};
struct EpiQ { static constexpr bool PERM = true;
    bf16_t* Q; const float* rstd;
    __device__ __forceinline__ void operator()(const AccT& acc, const Unit& u, int wr, int wc, int fr, int fq) const {
        const int row0 = u.pm * 256 + wr * 64 + fr, col0 = u.pn * 256 + wc * 32 + 8 * fq;
#pragma unroll
        for (int ai = 0; ai < 2; ++ai)
#pragma unroll
            for (int m = 0; m < 4; ++m) { const int row = row0 + ai * 128 + m * 16; const float sc = rstd[row] * QSCALE;
#pragma unroll
                for (int bj = 0; bj < 2; ++bj) *(u32x4*)(Q + (size_t)row * QW + col0 + bj * 128) = pack8(acc[ai][bj][m][0] * sc, acc[ai][bj][m][1] * sc); }
    }
};
struct EpiKV { static constexpr bool PERM = true;
    bf16_t* Kf; bf16_t* Vn; const float* rstd;
    __device__ __forceinline__ void operator()(const AccT& acc, const Unit& u, int wr, int wc, int fr, int fq) const {
        const int row0 = u.pm * 256 + wr * 64 + fr;
#pragma unroll
        for (int ai = 0; ai < 2; ++ai)
#pragma unroll
            for (int m = 0; m < 4; ++m) { const int row = row0 + ai * 128 + m * 16; const float sc = rstd[row];
#pragma unroll
                for (int bj = 0; bj < 2; ++bj) { const int n0 = u.pn * 256 + bj * 128 + wc * 32 + 8 * fq; const u32x4 w = pack8(acc[ai][bj][m][0] * sc, acc[ai][bj][m][1] * sc);
                    if (u.pn < 2) *(u32x4*)(Kf + (size_t)row * QW + (n0 >> 6) * 96 + (n0 & 63)) = w;
                    else *(u32x4*)(Vn + (size_t)row * 512 + (n0 - 512)) = w; } }
    }
};
struct EpiGlu { static constexpr bool PERM = true;
    const bf16_t* Z; bf16_t* O; const float* bias;
    __device__ __forceinline__ void operator()(const AccT& acc, const Unit& u, int wr, int wc, int fr, int fq) const {
        const int row0 = u.pm * 256 + wr * 64 + fr, col0 = u.pn * 256 + wc * 32 + 8 * fq;
#pragma unroll
        for (int bj = 0; bj < 2; ++bj) { const int col = col0 + bj * 128; const f32x4 b0 = *(const f32x4*)(bias + col), b1 = *(const f32x4*)(bias + col + 4);
#pragma unroll
            for (int ai = 0; ai < 2; ++ai)
#pragma unroll
                for (int m = 0; m < 4; ++m) { const int row = row0 + ai * 128 + m * 16; f32x4 z0, z1; unpack8(*(const u32x4*)(Z + (size_t)row * 512 + col), z0, z1);
                    f32x4 a0 = acc[ai][bj][m][0] + b0, a1 = acc[ai][bj][m][1] + b1;
#pragma unroll
                    for (int j = 0; j < 4; ++j) { a0[j] = z0[j] * sigmoidf_(a0[j]); a1[j] = z1[j] * sigmoidf_(a1[j]); }
                    *(u32x4*)(O + (size_t)row * INP + O_US5 + col) = pack8(a0, a1); asm volatile("" ::: "memory"); } }
    }
};
template <int MODE> struct EpiBranch { static constexpr bool PERM = true;
    const bf16_t* gate; bf16_t* merged;
    __device__ __forceinline__ void operator()(const AccT& acc, const Unit& u, int wr, int wc, int fr, int fq) const {
        const int row0 = u.pm * 256 + wr * 64 + fr, col0 = u.pn * 256 + wc * 32 + 8 * fq;
#pragma unroll
        for (int ai = 0; ai < 2; ++ai)
#pragma unroll
            for (int m = 0; m < 4; ++m) { const int row = row0 + ai * 128 + m * 16;
#pragma unroll
                for (int bj = 0; bj < 2; ++bj) { const int col = col0 + bj * 128; f32x4 g0, g1; unpack8(*(const u32x4*)(gate + (size_t)row * INP + col), g0, g1);
                    f32x4 a0 = acc[ai][bj][m][0], a1 = acc[ai][bj][m][1];
#pragma unroll
                    for (int j = 0; j < 4; ++j) { a0[j] *= sigmoidf_(g0[j]); a1[j] *= sigmoidf_(g1[j]); }
                    bf16_t* mp = merged + (size_t)row * DM + col;
                    if (MODE >= 1) { f32x4 p0, p1; unpack8(*(const u32x4*)mp, p0, p1); a0 += p0; a1 += p1; }
                    *(u32x4*)mp = pack8(a0, a1); asm volatile("" ::: "memory"); } }
    }
};
struct EpiRes { static constexpr bool PERM = false;
    const float* xres; float* pre; const float* gate;
    __device__ __forceinline__ void operator()(const AccT& acc, const Unit& u, int wr, int wc, int fr, int fq) const {
        const int row0 = u.pm * 256 + wr * 64 + fr, col0 = u.pn * 256 + wc * 32 + 4 * fq; const int b = (u.pm * 256) >> 12;
#pragma unroll
        for (int bj = 0; bj < 2; ++bj)
#pragma unroll
            for (int n = 0; n < 2; ++n) { const int col = col0 + bj * 128 + n * 16; const f32x4 gv = *(const f32x4*)(gate + b * 6144 + col) + 1.0f;
#pragma unroll
                for (int ai = 0; ai < 2; ++ai)
#pragma unroll
                    for (int m = 0; m < 4; ++m) { const size_t off = (size_t)(row0 + ai * 128 + m * 16) * DM + col;
                        const f32x4 xv = *(const f32x4*)(xres + off); *(f32x4*)(pre + off) = xv * ALPHA + gv * acc[ai][bj][m][n]; if (m & 1) asm volatile("" ::: "memory"); } }
    }
};
struct EpiFfn1 { static constexpr bool PERM = true;
    bf16_t* H;
    __device__ __forceinline__ void operator()(const AccT& acc, const Unit& u, int wr, int wc, int fr, int fq) const {
        const int row0 = u.pm * 256 + wr * 64 + fr, hc0 = u.pn * 128 + wc * 16 + 4 * fq;
#pragma unroll
        for (int ai = 0; ai < 2; ++ai)
#pragma unroll
            for (int m = 0; m < 4; ++m) { const int row = row0 + ai * 128 + m * 16;
#pragma unroll
                for (int bj = 0; bj < 2; ++bj) { const f32x4 a = acc[ai][bj][m][0], bb = acc[ai][bj][m][1]; u32x2 w;
                    w.x = cvt_pk_bf16(siluf_(a[0]) * bb[0], siluf_(a[1]) * bb[1]); w.y = cvt_pk_bf16(siluf_(a[2]) * bb[2], siluf_(a[3]) * bb[3]);
                    *(u32x2*)(H + (size_t)row * FF + hc0 + bj * 64) = w; } }
    }
};

#define XB_TMO      128
#define XB_XCNT(j)  (256  + 64 * (j))
#define XB_XSUB(j)  (1280 + 64 * (j))
#define XB_XGEN(j)  (2304 + 64 * (j))
#define XB_TOP      3328
#define XB_TOPGEN   3392
#define XCD_BAR_WORDS 3456
#define XB_SPIN_CAP (1u << 18)

__device__ __forceinline__ unsigned xb_ld(unsigned* p)              { return __hip_atomic_load(p, __ATOMIC_RELAXED, __HIP_MEMORY_SCOPE_AGENT); }
__device__ __forceinline__ unsigned xb_add(unsigned* p, unsigned v) { return __hip_atomic_fetch_add(p, v, __ATOMIC_RELAXED, __HIP_MEMORY_SCOPE_AGENT); }
__device__ __forceinline__ unsigned xb_xcc_id() { return (unsigned)__builtin_amdgcn_s_getreg((3 << 11) | 20) & 0xFu; }
#define XB_SPIN(cond, bar) do { unsigned _sp = 0; while (cond) { __builtin_amdgcn_s_sleep(1); \
    if ((++_sp & 255u) == 0u) { if (xb_ld(&(bar)[XB_TMO])) break; if (_sp > XB_SPIN_CAP) { atomicAdd(&(bar)[XB_TMO], 1u); break; } } } } while (0)

struct XcdBarrier {
    unsigned* bar; unsigned x;
    volatile LAS unsigned* st;
};

__device__ __forceinline__ XcdBarrier xcd_barrier_post(unsigned* bar, volatile LAS unsigned* st) {
    XcdBarrier b; b.bar = bar; b.x = xb_xcc_id(); b.st = st;
    if (threadIdx.x == 0) (void)xb_add(&bar[XB_XCNT(b.x)], 1u);
    return b;
}
__device__ __forceinline__ void xcd_barrier_complete(unsigned* bar, unsigned x, unsigned& nloc, unsigned& nx) {
    const unsigned G = gridDim.x * gridDim.y * gridDim.z;
    unsigned sum, cnt, mine, sp = 0u;
    for (;;) {
        sum = 0u; cnt = 0u; mine = 0u;
#pragma unroll
        for (unsigned j = 0; j < 16; ++j) { const unsigned c = xb_ld(&bar[XB_XCNT(j)]); sum += c; cnt += (c > 0u) ? 1u : 0u; mine = (j == x) ? c : mine; }
        if (sum == G) break;
        __builtin_amdgcn_s_sleep(1);
        if ((++sp & 255u) == 0u) { if (xb_ld(&bar[XB_TMO])) break; if (sp > XB_SPIN_CAP) { atomicAdd(&bar[XB_TMO], 1u); break; } }
    }
    nloc = mine > 0u ? mine : 1u; nx = cnt > 0u ? cnt : 1u;
}

__device__ __forceinline__ void xcd_barrier(const XcdBarrier& b) {
    asm volatile("s_waitcnt vmcnt(0)" ::: "memory");
    __syncthreads();
    if (threadIdx.x == 0) {
        unsigned* bar = b.bar;
        __builtin_amdgcn_s_waitcnt(0);
        unsigned nloc = b.st[0], nx = b.st[1];
        if (nloc == 0u) { xcd_barrier_complete(bar, b.x, nloc, nx); b.st[0] = nloc; b.st[1] = nx; }
        const unsigned old = xb_add(&bar[XB_XSUB(b.x)], 1u);
        const unsigned gen = old / nloc;
        if (old + 1u == (gen + 1u) * nloc) {
            __builtin_amdgcn_fence(__ATOMIC_RELEASE, "agent");
            asm volatile("s_waitcnt vmcnt(0)" ::: "memory");
            const unsigned og = xb_add(&bar[XB_TOP], 1u);
            const unsigned tg = og / nx;
            if (og + 1u == (tg + 1u) * nx) xb_add(&bar[XB_TOPGEN], 1u);
            else XB_SPIN(xb_ld(&bar[XB_TOPGEN]) == tg, bar);
            __builtin_amdgcn_fence(__ATOMIC_ACQUIRE, "agent");
            xb_add(&bar[XB_XGEN(b.x)], 1u);
            asm volatile("s_waitcnt vmcnt(0)" ::: "memory");
        } else {
            XB_SPIN(xb_ld(&bar[XB_XGEN(b.x)]) == gen, bar);
            __builtin_amdgcn_fence(__ATOMIC_ACQUIRE, "agent");
            asm volatile("s_waitcnt vmcnt(0)" ::: "memory");
        }
    }
    __syncthreads();
}

struct Params {
    const float* in[32];
    float* out;
    unsigned char* ws;
};
typedef const __attribute__((address_space(4))) unsigned char* kaptr_t;
typedef const __attribute__((address_space(4))) unsigned long long* kau64_t;
struct Ctx {
    kaptr_t ka;
    __device__ __forceinline__ const float* in(int k) const { return (const float*)(*(kau64_t)(ka + 8 * k)); }
    __device__ __forceinline__ float* out() const { return (float*)(*(kau64_t)(ka + 256)); }
    __device__ __forceinline__ unsigned char* wsb() const { return (unsigned char*)(*(kau64_t)(ka + 264)); }
#define WSP_(T, name, off) __device__ __forceinline__ T* name() const { return (T*)(wsb() + (off)); }
    WSP_(bf16_t, w_in, WS_W_IN) WSP_(bf16_t, w_q, WS_W_Q) WSP_(bf16_t, w_kv, WS_W_KV) WSP_(bf16_t, w_glu, WS_W_GLU) WSP_(bf16_t, w_br, WS_W_BR) WSP_(bf16_t, w_out, WS_W_OUT)
    WSP_(bf16_t, w_f1, WS_W_F1) WSP_(bf16_t, w_f2, WS_W_F2) WSP_(bf16_t, sguw, WS_SGUW) WSP_(bf16_t, s5bb, WS_S5BB) WSP_(bf16_t, s5cm, WS_S5CM)
    WSP_(float, b_inp, WS_B_INP) WSP_(float, s5a, WS_S5A) WSP_(float, s5a64, WS_S5A64) WSP_(float, ada, WS_ADA) WSP_(float, cosT, WS_COS) WSP_(float, sinT, WS_SIN)
    WSP_(float, rstd_q, WS_STAT) WSP_(float, rstd_kv, WS_STAT + 65536) WSP_(float, sgu_mean, WS_STAT + 131072) WSP_(float, sgu_rstd, WS_STAT + 196608) WSP_(float, ebuf, WS_EBUF)
    WSP_(float, xcur, WS_XCUR) WSP_(float, pre, WS_PRE) WSP_(bf16_t, proj, WS_PROJ) WSP_(bf16_t, hid, WS_PROJ) WSP_(bf16_t, kf, WS_KF) WSP_(bf16_t, vt, WS_VT) WSP_(bf16_t, zb, WS_Z)
    WSP_(bf16_t, hb, WS_HB) WSP_(bf16_t, merged, WS_HB) WSP_(bf16_t, qb, WS_QB)
#undef WSP_
};
__device__ __forceinline__ Ctx mk_ctx() { kaptr_t ka = (kaptr_t)__builtin_amdgcn_kernarg_segment_ptr(); asm volatile("" : "+s"(ka)); return Ctx{ka}; }
#define NEWCTX const Ctx C = mk_ctx()

template <int PERMT> __device__ __forceinline__ int perm_src(int n) {
    if (PERMT == 1) { return n < 512 ? (n >> 6) * 96 + (n & 63) : ((n - 512) >> 5) * 96 + 64 + ((n - 512) & 31); }
    if (PERMT == 2) { return n < 512 ? (n >> 6) * 128 + (n & 63) : ((n - 512) >> 6) * 128 + 64 + ((n - 512) & 63); }
    if (PERMT == 3) { const int q = n >> 3, r = n & 7; return r < 4 ? q * 4 + r : FF + q * 4 + (r - 4); }
    return n;
}
template <int PERMT> __device__ __forceinline__ void cvt_weight(const float* src, bf16_t* dst, const float* scale, int K, int Nsrc, int Nout, LAS unsigned char* lds) {
    LAS float* T = (LAS float*)lds;
    int tid = threadIdx.x; asm volatile("" : "+v"(tid));
    const int tk = K >> 6, tn = Nout >> 6, ntile = tk * tn;
    const int rk = tid >> 4, rq = tid & 15;
    const int wn = tid >> 3, wq = tid & 7;
#pragma unroll 1
    for (int t = blockIdx.x; t < ntile; t += gridDim.x) {
        const int k0 = (t % tk) * 64, n0 = (t / tk) * 64;
        const int sc = perm_src<PERMT>(n0 + rq * 4);
#pragma unroll
        for (int i = 0; i < 2; ++i) { const int kk = rk + 32 * i; f32x4 v = {0.f, 0.f, 0.f, 0.f};
            if (sc < Nsrc) v = *(const f32x4*)(src + (size_t)(k0 + kk) * Nsrc + sc);
            if (scale) v = v * scale[k0 + kk];
            *(LAS f32x4*)(T + kk * 68 + rq * 4) = v; }
        __syncthreads();
        { float e[8];
#pragma unroll
          for (int j = 0; j < 8; ++j) e[j] = T[(wq * 8 + j) * 68 + wn];
          u32x4 w; w.x = cvt_pk_bf16(e[0], e[1]); w.y = cvt_pk_bf16(e[2], e[3]); w.z = cvt_pk_bf16(e[4], e[5]); w.w = cvt_pk_bf16(e[6], e[7]);
          *(u32x4*)(dst + (size_t)(n0 + wn) * K + k0 + wq * 8) = w; }
        __syncthreads();
    }
}
__device__ __forceinline__ void convert_layer(const Ctx& C, int l, LAS unsigned char* lds) {
    cvt_weight<0>(C.in(4) + (size_t)l * 1024 * INW, C.w_in(), nullptr, 1024, INW, INP, lds);
    cvt_weight<1>(C.in(17) + (size_t)l * 384 * 768, C.w_q(), C.in(16) + l * 384, 384, 768, 768, lds);
    cvt_weight<2>(C.in(19) + (size_t)l * 256 * 1024, C.w_kv(), C.in(18) + l * 256, 256, 1024, 1024, lds);
    cvt_weight<0>(C.in(14) + (size_t)l * 512 * 512, C.w_glu(), nullptr, 512, 512, 512, lds);
#pragma unroll 1
    for (int b = 0; b < 3; ++b) cvt_weight<0>(C.in(24) + ((size_t)l * 3 + b) * 512 * 1024, C.w_br() + (size_t)b * 1024 * 512, nullptr, 512, 1024, 1024, lds);
    cvt_weight<0>(C.in(25) + (size_t)l * 1024 * 1024, C.w_out(), nullptr, 1024, 1024, 1024, lds);
    cvt_weight<3>(C.in(28) + (size_t)l * 1024 * FF2, C.w_f1(), nullptr, 1024, FF2, FF2, lds);
    cvt_weight<0>(C.in(29) + (size_t)l * FF * 1024, C.w_f2(), nullptr, FF, 1024, 1024, lds);
    int tid2 = threadIdx.x; asm volatile("" : "+v"(tid2));
    const int gt = blockIdx.x * 512 + tid2, gs = gridDim.x * 512;
    for (int i = gt; i < INP; i += gs) C.b_inp()[i] = i < INW ? C.in(5)[(size_t)l * INW + i] : 0.f;
    for (int i = gt; i < 4 * 128 * 128; i += gs) { const int ii = (i >> 7) & 127, jj = i & 127; C.sguw()[i] = f2bf(((jj >> 6) <= (ii >> 6)) ? C.in(22)[(size_t)l * 65536 + i] : 0.f); }
#pragma unroll 1
    for (int i = gt; i < 2048; i += gs) {
        const int g = i >> 6, p = i & 63;
        const float dt = expf(C.in(8)[l * 32 + g]), lr = C.in(6)[l * 2048 + i], li = C.in(7)[l * 2048 + i];
        const float mag = expf(lr * dt); float sn, cs; sincos_rr(li * dt, sn, cs);
        const float are = mag * cs, aim = mag * sn, den = lr * lr + li * li;
        const float fre = ((are - 1.0f) * lr + aim * li) / den, fim = (aim * lr - (are - 1.0f) * li) / den;
        const float* br = C.in(9) + (size_t)l * 32768 + (size_t)i * 16; const float* bi = C.in(10) + (size_t)l * 32768 + (size_t)i * 16;
#pragma unroll
        for (int c = 0; c < 16; ++c) { const float r_ = br[c], i_ = bi[c];
            C.s5bb()[(size_t)(g * 128 + p) * 16 + c] = f2bf(fre * r_ - fim * i_); C.s5bb()[(size_t)(g * 128 + 64 + p) * 16 + c] = f2bf(fre * i_ + fim * r_); }
        C.s5a()[i * 2] = are; C.s5a()[i * 2 + 1] = aim;
        float pr = are, pi = aim;
#pragma unroll
        for (int s = 0; s < 6; ++s) { const float nr = pr * pr - pi * pi, ni = 2.0f * pr * pi; pr = nr; pi = ni; }
        C.s5a64()[i * 2] = pr; C.s5a64()[i * 2 + 1] = pi;
        const float* cr = C.in(11) + (size_t)l * 32768 + (size_t)g * 1024 + p; const float* ci = C.in(12) + (size_t)l * 32768 + (size_t)g * 1024 + p;
#pragma unroll
        for (int c = 0; c < 16; ++c) { C.s5cm()[(size_t)(g * 16 + c) * 128 + p] = f2bf(cr[c * 64]); C.s5cm()[(size_t)(g * 16 + c) * 128 + 64 + p] = f2bf(-ci[c * 64]); }
    }
}
__device__ __forceinline__ void ada_tables(const Ctx& C, LAS unsigned char* lds) {
    LAS float* cact = (LAS float*)lds;
    LAS float* red = (LAS float*)(lds + 16384);
    const int tid = threadIdx.x, lane = tid & 63, wid = tid >> 6;
    for (int i = tid; i < 4096; i += 512) cact[i] = siluf_(C.in(1)[i]);
    __syncthreads();
    for (int u = blockIdx.x; u < 4 * 96; u += gridDim.x) {
        const int l = u / 96, n = (u % 96) * 64 + lane;
        const float* w = C.in(2) + (size_t)l * 1024 * 6144 + n;
        float a0 = 0.f, a1 = 0.f, a2 = 0.f, a3 = 0.f;
        for (int k = wid * 128; k < wid * 128 + 128; ++k) { const float wv = w[(size_t)k * 6144]; a0 += cact[k] * wv; a1 += cact[1024 + k] * wv; a2 += cact[2048 + k] * wv; a3 += cact[3072 + k] * wv; }
        red[(wid * 4 + 0) * 64 + lane] = a0; red[(wid * 4 + 1) * 64 + lane] = a1; red[(wid * 4 + 2) * 64 + lane] = a2; red[(wid * 4 + 3) * 64 + lane] = a3;
        __syncthreads();
        if (tid < 256) { const int b = tid >> 6; float s = 0.f;
#pragma unroll
            for (int w8 = 0; w8 < 8; ++w8) s += red[(w8 * 4 + b) * 64 + lane];
            C.ada()[(size_t)(l * 4 + b) * 6144 + n] = s + C.in(3)[(size_t)l * 6144 + n]; }
        __syncthreads();
    }
    for (int i = blockIdx.x * 512 + tid; i < 4096 * 16; i += gridDim.x * 512) { const float ang = (float)(i >> 4) * INV_FREQ[i & 15]; float s, c; sincos_rr(ang, s, c); C.cosT()[i] = c; C.sinT()[i] = s; }
}
__device__ __forceinline__ void mod_x0(const Ctx& C) {
    const float* x = C.in(0);
    for (size_t i = (size_t)blockIdx.x * 512 + threadIdx.x; i < (size_t)MTOK * DM / 4; i += (size_t)gridDim.x * 512) {
        const size_t e = i * 4; const int row = (int)(e >> 10), col = (int)(e & 1023), b = row >> 12;
        const f32x4 xv = *(const f32x4*)(x + e), sh = *(const f32x4*)(C.ada() + b * 6144 + col), sc = *(const f32x4*)(C.ada() + b * 6144 + 1024 + col);
        const f32x4 h = xv * (sc + 1.0f) + sh; u32x2 w; w.x = cvt_pk_bf16(h[0], h[1]); w.y = cvt_pk_bf16(h[2], h[3]); *(u32x2*)(C.hb() + e) = w;
    }
}
__device__ __forceinline__ void ln_pass(const float* pre, const float* g, const float* bta, float* xout, bf16_t* hb, const float* sh, const float* sc) {
    const int lane = threadIdx.x & 63, wid = threadIdx.x >> 6;
    for (int row = blockIdx.x * 8 + wid; row < MTOK; row += gridDim.x * 8) {
        const float* p = pre + (size_t)row * DM; f32x4 v[4]; float s = 0.f;
#pragma unroll
        for (int i = 0; i < 4; ++i) { v[i] = *(const f32x4*)(p + i * 256 + lane * 4); s += (v[i][0] + v[i][1]) + (v[i][2] + v[i][3]); }
        const float mean = wave_sum(s) * (1.0f / 1024.0f); float q = 0.f;
#pragma unroll
        for (int i = 0; i < 4; ++i) { const f32x4 d = v[i] - mean; q += (d[0] * d[0] + d[1] * d[1]) + (d[2] * d[2] + d[3] * d[3]); }
        const float rstd = rsqrtf(wave_sum(q) * (1.0f / 1024.0f) + 1e-5f); const int b = row >> 12;
#pragma unroll
        for (int i = 0; i < 4; ++i) { const int col = i * 256 + lane * 4; const f32x4 xn = (v[i] - mean) * rstd * *(const f32x4*)(g + col) + *(const f32x4*)(bta + col);
            *(f32x4*)(xout + (size_t)row * DM + col) = xn;
            if (hb) { const f32x4 h = xn * (*(const f32x4*)(sc + b * 6144 + col) + 1.0f) + *(const f32x4*)(sh + b * 6144 + col); u32x2 w; w.x = cvt_pk_bf16(h[0], h[1]); w.y = cvt_pk_bf16(h[2], h[3]); *(u32x2*)(hb + (size_t)row * DM + col) = w; } }
    }
}
__device__ __forceinline__ void token_prepass(const Ctx& C) {
    const int lane = threadIdx.x & 63, wid = threadIdx.x >> 6;
    for (int row = blockIdx.x * 8 + wid; row < MTOK; row += gridDim.x * 8) {
        const bf16_t* pr = C.proj() + (size_t)row * INP;
        float ss = 0.f;
        if (lane < 48) { f32x4 a, b; unpack8(*(const u32x4*)(pr + O_CQ + lane * 8), a, b); ss = (a[0] * a[0] + a[1] * a[1]) + (a[2] * a[2] + a[3] * a[3]) + (b[0] * b[0] + b[1] * b[1]) + (b[2] * b[2] + b[3] * b[3]); }
        const float rq = rsqrtf(wave_sum(ss) * (1.0f / 384.0f) + 1e-6f);
        ss = 0.f;
        if (lane < 32) { f32x4 a, b; unpack8(*(const u32x4*)(pr + O_CKV + lane * 8), a, b); ss = (a[0] * a[0] + a[1] * a[1]) + (a[2] * a[2] + a[3] * a[3]) + (b[0] * b[0] + b[1] * b[1]) + (b[2] * b[2] + b[3] * b[3]); }
        const float rkv = rsqrtf(wave_sum(ss) * (1.0f / 256.0f) + 1e-6f);
        f32x4 a, b; unpack8(*(const u32x4*)(pr + O_VSGU + lane * 8), a, b);
#pragma unroll
        for (int j = 0; j < 4; ++j) { a[j] = geluf_(a[j]); b[j] = geluf_(b[j]); }
        const float mean = wave_sum((a[0] + a[1]) + (a[2] + a[3]) + (b[0] + b[1]) + (b[2] + b[3])) * (1.0f / 512.0f);
        a = a - mean; b = b - mean;
        const float var = wave_sum((a[0] * a[0] + a[1] * a[1]) + (a[2] * a[2] + a[3] * a[3]) + (b[0] * b[0] + b[1] * b[1]) + (b[2] * b[2] + b[3] * b[3])) * (1.0f / 512.0f);
        if (lane == 0) { C.rstd_q()[row] = rq; C.rstd_kv()[row] = rkv; C.sgu_mean()[row] = mean; C.sgu_rstd()[row] = rsqrtf(var + 1e-5f); }
        if (lane < 16) { const float x1 = bf2f(pr[O_KPE + lane]), x2 = bf2f(pr[O_KPE + 16 + lane]); const int pos = row & (SEQ - 1); const float cs = C.cosT()[pos * 16 + lane], sn = C.sinT()[pos * 16 + lane];
            const bf16_t o1 = f2bf(x1 * cs - x2 * sn), o2 = f2bf(x2 * cs + x1 * sn); bf16_t* kp = C.kf() + (size_t)row * QW + 64 + lane;
#pragma unroll
            for (int h = 0; h < 8; ++h) { kp[h * 96] = o1; kp[h * 96 + 16] = o2; } }
    }
}
__device__ __forceinline__ void sgu_phase(const Ctx& C, int l, LAS unsigned char* lds) {
    int tid = threadIdx.x; asm volatile("" : "+v"(tid));
    const int lane = tid & 63, wid = tid >> 6, fr = lane & 15, fq = lane >> 4;
    const float* ln_g = C.in(20) + l * 512; const float* ln_b = C.in(21) + l * 512; const float* b_s = C.in(23) + l * 512;
    for (int u = blockIdx.x; u < 512; u += gridDim.x) {
        const int n = u >> 2, g = u & 3, r0 = n * 128, c0 = g * 128;
#pragma unroll
        for (int i = 0; i < 4; ++i) { const int p = tid + 512 * i, j = p & 127, cp = p >> 7; const size_t row = r0 + j;
            f32x4 a, b; unpack8(*(const u32x4*)(C.proj() + row * INP + O_VSGU + c0 + cp * 8), a, b);
            const float mean = C.sgu_mean()[row], rstd = C.sgu_rstd()[row]; const f32x4 g0 = *(const f32x4*)(ln_g + c0 + cp * 8), g1 = *(const f32x4*)(ln_g + c0 + cp * 8 + 4), b0 = *(const f32x4*)(ln_b + c0 + cp * 8), b1 = *(const f32x4*)(ln_b + c0 + cp * 8 + 4);
#pragma unroll
            for (int e = 0; e < 4; ++e) { *(LAS bf16_t*)(lds + (cp * 8 + e) * 272 + j * 2) = f2bf((geluf_(a[e]) - mean) * rstd * g0[e] + b0[e]);
                                          *(LAS bf16_t*)(lds + (cp * 8 + 4 + e) * 272 + j * 2) = f2bf((geluf_(b[e]) - mean) * rstd * g1[e] + b1[e]); } }
        __syncthreads();
        bf16x8 af[4];
#pragma unroll
        for (int ks = 0; ks < 4; ++ks) af[ks] = *(const bf16x8*)(C.sguw() + (size_t)(g * 128 + 16 * wid + fr) * 128 + ks * 32 + fq * 8);
#pragma unroll
        for (int nt = 0; nt < 8; ++nt) { f32x4 acc = {0.f, 0.f, 0.f, 0.f};
#pragma unroll
            for (int ks = 0; ks < 4; ++ks) { const bf16x8 bfr = *(const LAS bf16x8*)(lds + (nt * 16 + fr) * 272 + (ks * 32 + fq * 8) * 2); acc = __builtin_amdgcn_mfma_f32_16x16x32_bf16(bfr, af[ks], acc, 0, 0, 0); }
            { const int i = 16 * wid + fr; const float bs = b_s[g * 128 + i]; bf16_t* pu = C.proj() + (size_t)(r0 + i) * INP + O_USGU + c0 + nt * 16 + 4 * fq;
              const u32x2 uw = *(const u32x2*)pu; u32x2 yw;
              yw.x = cvt_pk_bf16(geluf_(bflo(uw.x)) * (acc[0] + bs), geluf_(bfhi(uw.x)) * (acc[1] + bs)); yw.y = cvt_pk_bf16(geluf_(bflo(uw.y)) * (acc[2] + bs), geluf_(bfhi(uw.y)) * (acc[3] + bs));
              *(u32x2*)pu = yw; } }
        __syncthreads();
    }
}
template <bool FINAL> __device__ __forceinline__ void s5_phase(const Ctx& C, int l, LAS unsigned char* lds) {
    int tid = threadIdx.x; asm volatile("" : "+v"(tid));
    const int lane = tid & 63, wid = __builtin_amdgcn_readfirstlane(tid >> 6), r32 = lane & 31, hi = lane >> 5, fr = lane & 15, fq = lane >> 4;
    LAS unsigned char* wl = lds + wid * 16896;
    const float* dvec = C.in(13) + l * 512;
    for (int wu = blockIdx.x * 8 + wid; wu < 8192; wu += gridDim.x * 8) {
        const int m = wu >> 5, g = wu & 31, p = lane;
        const float are = C.s5a()[(g * 64 + p) * 2], aim = C.s5a()[(g * 64 + p) * 2 + 1];
        float hre = 0.f, him = 0.f;
        if (FINAL) { const int k = m & 63, mb = m - k; const float a64r = C.s5a64()[(g * 64 + p) * 2], a64i = C.s5a64()[(g * 64 + p) * 2 + 1];
            const float* eb = C.ebuf() + ((size_t)mb * 32 + g) * 128 + p;
            for (int jb = k - ((k + 7) & ~7); jb < k; jb += 8) {
                float er[8], ei[8];
#pragma unroll
                for (int i = 0; i < 8; ++i) { const int j = jb + i; const float* e = eb + (size_t)(j < 0 ? 0 : j) * 4096; er[i] = e[0]; ei[i] = e[64]; if (j < 0) { er[i] = 0.f; ei[i] = 0.f; } }
#pragma unroll
                for (int i = 0; i < 8; ++i) { const float nr = a64r * hre - a64i * him + er[i], ni = a64r * him + a64i * hre + ei[i]; hre = nr; him = ni; } } }
        bf16x8 bfr[4];
#pragma unroll
        for (int pt = 0; pt < 4; ++pt) bfr[pt] = *(const bf16x8*)(C.s5bb() + (size_t)(g * 128 + pt * 32 + r32) * 16 + hi * 8);
        for (int half = 0; half < 2; ++half) {
            const int t0 = m * 64 + half * 32;
            const bf16x8 afr = *(const bf16x8*)(C.proj() + (size_t)(t0 + r32) * INP + O_US5 + g * 16 + hi * 8);
#pragma unroll
            for (int pt = 0; pt < 4; ++pt) { f32x16 d = {}; d = __builtin_amdgcn_mfma_f32_32x32x16_bf16(afr, bfr[pt], d, 0, 0, 0);
#pragma unroll
                for (int r = 0; r < 16; ++r) { const int t = 8 * (r >> 2) + 4 * hi + (r & 3); *(LAS float*)(wl + t * 528 + (pt * 32 + r32) * 4) = d[r]; } }
            asm volatile("s_waitcnt lgkmcnt(0)" ::: "memory");
#pragma unroll
            for (int t = 0; t < 32; ++t) { const float br = *(const LAS float*)(wl + t * 528 + p * 4), bi = *(const LAS float*)(wl + t * 528 + 256 + p * 4);
                const float nr = are * hre - aim * him + br, ni = are * him + aim * hre + bi; hre = nr; him = ni;
                if (FINAL) { *(LAS bf16_t*)(wl + t * 528 + p * 2) = f2bf(nr); *(LAS bf16_t*)(wl + t * 528 + 128 + p * 2) = f2bf(ni); } }
            if (FINAL) {
                asm volatile("s_waitcnt lgkmcnt(0)" ::: "memory");
#pragma unroll
                for (int tt = 0; tt < 2; ++tt) { f32x4 acc = {0.f, 0.f, 0.f, 0.f};
#pragma unroll
                    for (int ks = 0; ks < 4; ++ks) { const bf16x8 a = *(const LAS bf16x8*)(wl + (tt * 16 + fr) * 528 + (ks * 32 + fq * 8) * 2);
                        const bf16x8 b = *(const bf16x8*)(C.s5cm() + (size_t)(g * 16 + fr) * 128 + ks * 32 + fq * 8); acc = __builtin_amdgcn_mfma_f32_16x16x32_bf16(b, a, acc, 0, 0, 0); }
                    const int c = g * 16 + 4 * fq; const f32x4 dd = *(const f32x4*)(dvec + c); const size_t tok = (size_t)(t0 + tt * 16 + fr);
                    const u32x2 uw = *(const u32x2*)(C.proj() + tok * INP + O_US5 + c);
                    u32x2 zw; zw.x = cvt_pk_bf16(geluf_(acc[0] + dd[0] * bflo(uw.x)), geluf_(acc[1] + dd[1] * bfhi(uw.x))); zw.y = cvt_pk_bf16(geluf_(acc[2] + dd[2] * bflo(uw.y)), geluf_(acc[3] + dd[3] * bfhi(uw.y)));
                    *(u32x2*)(C.zb() + tok * 512 + c) = zw; }
                asm volatile("s_waitcnt lgkmcnt(0)" ::: "memory");
            }
        }
        if (!FINAL) { float* e = C.ebuf() + ((size_t)m * 32 + g) * 128 + p; e[0] = hre; e[64] = him; }
    }
}
__device__ __forceinline__ void attn_unit(const Ctx& C, int b, int h, int qb, LAS unsigned char* lds, bool dummy = false) {
    int tid = threadIdx.x; asm volatile("" : "+v"(tid));
    const int lane = tid & 63, wid = __builtin_amdgcn_readfirstlane(tid >> 6), r32 = lane & 31, hi = lane >> 5;
    const int NT = 4 * qb + 4, cw = 4 * qb + (wid >> 1);
    const size_t qrow = (size_t)b * SEQ + 256 * qb + 32 * wid + r32;
    bf16x8 qf[6];
#pragma unroll
    for (int ds = 0; ds < 4; ++ds) qf[ds] = *(const bf16x8*)(C.qb() + qrow * QW + h * 64 + ds * 16 + hi * 8);
    {
      f32x4 a0, a1, b0, b1; unpack8(*(const u32x4*)(C.qb() + qrow * QW + 512 + h * 32 + hi * 8), a0, a1); unpack8(*(const u32x4*)(C.qb() + qrow * QW + 512 + h * 32 + 16 + hi * 8), b0, b1);
      const int pos = (int)(qrow & (SEQ - 1)); const float* cp = C.cosT() + pos * 16 + hi * 8; const float* sp = C.sinT() + pos * 16 + hi * 8;
      const f32x4 c0 = *(const f32x4*)cp, c1 = *(const f32x4*)(cp + 4), s0 = *(const f32x4*)sp, s1 = *(const f32x4*)(sp + 4);
      qf[4] = __builtin_bit_cast(bf16x8, pack8(a0 * c0 - b0 * s0, a1 * c1 - b1 * s1)); qf[5] = __builtin_bit_cast(bf16x8, pack8(b0 * c0 + a0 * s0, b1 * c1 + a1 * s1)); }
    f32x16 o0 = {}, o1 = {}; float mrun = -1e30f, lrun = 0.f;
    const bf16_t* kbase = C.kf() + (size_t)b * SEQ * QW + h * 96;
    const bf16_t* vbase = C.vt() + (size_t)b * SEQ * 512 + h * 64;
    const int kk0 = tid / 12, pc0 = tid % 12, p1 = 512 + tid, kk1 = p1 / 12, pc1 = p1 % 12; const bool has1 = tid < 256;
    u32x4 kr0, kr1 = {0u, 0u, 0u, 0u}, vr;
#define ATT_LOAD(t) do { kr0 = *(const u32x4*)(kbase + (size_t)((t) * 64 + kk0) * QW + pc0 * 8); if (has1) kr1 = *(const u32x4*)(kbase + (size_t)((t) * 64 + kk1) * QW + pc1 * 8); \
        vr = *(const u32x4*)(vbase + (size_t)((t) * 64 + lane) * 512 + wid * 8); } while (0)
#define ATT_STORE(bf) do { LAS unsigned char* bb_ = lds + (bf) * 22016; *(LAS u32x4*)(bb_ + kk0 * 208 + pc0 * 16) = kr0; if (has1) *(LAS u32x4*)(bb_ + kk1 * 208 + pc1 * 16) = kr1; \
        LAS unsigned char* vv_ = bb_ + 13312 + (wid * 8) * 136 + lane * 2; \
        *(LAS bf16_t*)(vv_) = (bf16_t)vr.x; *(LAS bf16_t*)(vv_ + 136) = (bf16_t)(vr.x >> 16); *(LAS bf16_t*)(vv_ + 2 * 136) = (bf16_t)vr.y; *(LAS bf16_t*)(vv_ + 3 * 136) = (bf16_t)(vr.y >> 16); \
        *(LAS bf16_t*)(vv_ + 4 * 136) = (bf16_t)vr.z; *(LAS bf16_t*)(vv_ + 5 * 136) = (bf16_t)(vr.z >> 16); *(LAS bf16_t*)(vv_ + 6 * 136) = (bf16_t)vr.w; *(LAS bf16_t*)(vv_ + 7 * 136) = (bf16_t)(vr.w >> 16); } while (0)
    ATT_LOAD(0); ATT_STORE(0); __syncthreads();
    for (int t = 0; t < NT; ++t) {
        if (t + 1 < NT) ATT_LOAD(t + 1);
        if (t <= cw) {
            const LAS unsigned char* kb = lds + (t & 1) * 22016; const LAS unsigned char* vb = kb + 13312;
            f32x16 p0 = {}, p1v = {};
#pragma unroll
            for (int ds = 0; ds < 6; ++ds) { const bf16x8 a0 = *(const LAS bf16x8*)(kb + r32 * 208 + (ds * 16 + hi * 8) * 2), a1 = *(const LAS bf16x8*)(kb + (32 + r32) * 208 + (ds * 16 + hi * 8) * 2);
                p0 = __builtin_amdgcn_mfma_f32_32x32x16_bf16(a0, qf[ds], p0, 0, 0, 0); p1v = __builtin_amdgcn_mfma_f32_32x32x16_bf16(a1, qf[ds], p1v, 0, 0, 0); }
            float mx = fmaxf(p0[0], p1v[0]);
#pragma unroll
            for (int r = 1; r < 16; ++r) mx = fmaxf(mx, fmaxf(p0[r], p1v[r]));
            mx = fmaxf(mx, __shfl_xor(mx, 32));
            const float mn = fmaxf(mrun, mx), alpha = fexp2(mrun - mn); mrun = mn;
            float rs = 0.f;
#pragma unroll
            for (int r = 0; r < 16; ++r) { p0[r] = fexp2(p0[r] - mn); p1v[r] = fexp2(p1v[r] - mn); rs += p0[r] + p1v[r]; }
            lrun = lrun * alpha + rs;
#pragma unroll
            for (int r = 0; r < 16; ++r) { o0[r] *= alpha; o1[r] *= alpha; }
            bf16x8 pf[4];
            { u32x4 w;
              w.x = cvt_pk_bf16(p0[0], p0[1]); w.y = cvt_pk_bf16(p0[2], p0[3]); w.z = cvt_pk_bf16(p0[4], p0[5]); w.w = cvt_pk_bf16(p0[6], p0[7]); pf[0] = __builtin_bit_cast(bf16x8, w);
              w.x = cvt_pk_bf16(p0[8], p0[9]); w.y = cvt_pk_bf16(p0[10], p0[11]); w.z = cvt_pk_bf16(p0[12], p0[13]); w.w = cvt_pk_bf16(p0[14], p0[15]); pf[1] = __builtin_bit_cast(bf16x8, w);
              w.x = cvt_pk_bf16(p1v[0], p1v[1]); w.y = cvt_pk_bf16(p1v[2], p1v[3]); w.z = cvt_pk_bf16(p1v[4], p1v[5]); w.w = cvt_pk_bf16(p1v[6], p1v[7]); pf[2] = __builtin_bit_cast(bf16x8, w);
              w.x = cvt_pk_bf16(p1v[8], p1v[9]); w.y = cvt_pk_bf16(p1v[10], p1v[11]); w.z = cvt_pk_bf16(p1v[12], p1v[13]); w.w = cvt_pk_bf16(p1v[14], p1v[15]); pf[3] = __builtin_bit_cast(bf16x8, w); }
#pragma unroll
            for (int ks = 0; ks < 4; ++ks) {
                { const u32x2 lo = *(const LAS u32x2*)(vb + r32 * 136 + (16 * ks + 4 * hi) * 2), hh = *(const LAS u32x2*)(vb + r32 * 136 + (16 * ks + 8 + 4 * hi) * 2);
                  const u32x4 w = {lo.x, lo.y, hh.x, hh.y}; o0 = __builtin_amdgcn_mfma_f32_32x32x16_bf16(__builtin_bit_cast(bf16x8, w), pf[ks], o0, 0, 0, 0); }
                { const u32x2 lo = *(const LAS u32x2*)(vb + (32 + r32) * 136 + (16 * ks + 4 * hi) * 2), hh = *(const LAS u32x2*)(vb + (32 + r32) * 136 + (16 * ks + 8 + 4 * hi) * 2);
                  const u32x4 w = {lo.x, lo.y, hh.x, hh.y}; o1 = __builtin_amdgcn_mfma_f32_32x32x16_bf16(__builtin_bit_cast(bf16x8, w), pf[ks], o1, 0, 0, 0); }
            }
        }
        if (t + 1 < NT) ATT_STORE((t + 1) & 1);
        __syncthreads();
    }
#undef ATT_LOAD
#undef ATT_STORE
    const float linv = 1.0f / (lrun + __shfl_xor(lrun, 32));
    bf16_t* op = C.qb() + qrow * QW + h * 64 + 4 * hi;
    if (dummy && linv != 123.456f) return;
#pragma unroll
    for (int g4 = 0; g4 < 4; ++g4) {
        u32x2 w; w.x = cvt_pk_bf16(o0[4 * g4] * linv, o0[4 * g4 + 1] * linv); w.y = cvt_pk_bf16(o0[4 * g4 + 2] * linv, o0[4 * g4 + 3] * linv); *(u32x2*)(op + 8 * g4) = w;
        w.x = cvt_pk_bf16(o1[4 * g4] * linv, o1[4 * g4 + 1] * linv); w.y = cvt_pk_bf16(o1[4 * g4 + 2] * linv, o1[4 * g4 + 3] * linv); *(u32x2*)(op + 32 + 8 * g4) = w;
    }
}
__device__ __forceinline__ void attn_phase(const Ctx& C, LAS unsigned char* lds) {
    for (int pi = blockIdx.x; pi < 256; pi += gridDim.x) {
        const int xcd = pi & 7, k = pi >> 3, bh = xcd * 4 + (k >> 3), j = k & 7, b = bh >> 3, h = bh & 7;
        if ((PROBE_MASK >> 1) & 1) { attn_unit(C, b, h, 15 - j, lds, true); attn_unit(C, b, h, j, lds, true); }
        attn_unit(C, b, h, 15 - j, lds);
        attn_unit(C, b, h, j, lds);
    }
}

__global__ void __launch_bounds__(512, 2) fwd_megakernel(Params P) {
    extern __shared__ __attribute__((aligned(16))) unsigned char lds_raw[];
    LAS unsigned char* lds = (LAS unsigned char*)lds_raw;
    cg::grid_group grid = cg::this_grid();
    if (threadIdx.x < 4) ((LAS unsigned*)(lds + LDS_PHASE))[threadIdx.x] = 0u;
    __syncthreads();
    (void)xcd_barrier_post((unsigned*)(mk_ctx().wsb() + WS_BAR), (volatile LAS unsigned*)(lds + LDS_PHASE));
#define GSYNC() do { XcdBarrier xb_; xb_.bar = (unsigned*)(mk_ctx().wsb() + WS_BAR); xb_.x = xb_xcc_id(); xb_.st = (volatile LAS unsigned*)(lds + LDS_PHASE); xcd_barrier(xb_); } while (0)
    const int G = gridDim.x, cid = blockIdx.x;

    { NEWCTX;
#if !defined(NO_CONV)
      convert_layer(C, 0, lds);
#endif
    }
    { NEWCTX;
#if !defined(NO_ADA)
      ada_tables(C, lds);
#endif
    }
    grid.sync();
    { NEWCTX; mod_x0(C); }
    GSYNC();

#pragma unroll 1
    for (int l = 0; l < DEPTH; ++l) {
        pg8::StaticOrder S;
        { NEWCTX; pg8::Gemm g{C.hb(), C.w_in(), MTOK, INP, 1024, 1024}; S.init(MTOK, INP, G, cid); EpiProj E{C.proj(), C.b_inp()}; REP(0) pg8::gemm_phase(lds, g, S, E); }
        GSYNC();
        { NEWCTX;
#if !defined(NO_PRE)
          REP(3) token_prepass(C);
#endif
        }
        GSYNC();
        { NEWCTX; pg8::Gemm g{C.proj() + O_CQ, C.w_q(), MTOK, 768, 384, INP}; S.init(MTOK, 768, G, cid); EpiQ E{C.qb(), C.rstd_q()}; REP(0) pg8::gemm_phase(lds, g, S, E); }
        { NEWCTX; pg8::Gemm g{C.proj() + O_CKV, C.w_kv(), MTOK, 1024, 256, INP}; S.init(MTOK, 1024, G, cid); EpiKV E{C.kf(), C.vt(), C.rstd_kv()}; REP(0) pg8::gemm_phase(lds, g, S, E); }
        __syncthreads();
        { NEWCTX;
#if !defined(NO_SGU)
          sgu_phase(C, l, lds);
#endif
        }
        { NEWCTX;
#if !defined(NO_S5)
          REP(2) s5_phase<false>(C, l, lds);
#endif
        }
        GSYNC();
        { NEWCTX;
#if !defined(NO_ATT)
          attn_phase(C, lds);
#endif
        }
        __syncthreads();
        { NEWCTX;
#if !defined(NO_S5)
          REP(2) s5_phase<true>(C, l, lds);
#endif
        }
        GSYNC();
        { NEWCTX; pg8::Gemm g{C.zb(), C.w_glu(), MTOK, 512, 512, 512}; S.init(MTOK, 512, G, cid); EpiGlu E{C.zb(), C.proj(), C.in(15) + l * 512}; REP(0) pg8::gemm_phase(lds, g, S, E); }
        GSYNC();
        S.init(MTOK, 1024, G, cid);
        { NEWCTX; pg8::Gemm g{C.proj() + O_US5, C.w_br(), MTOK, 1024, 512, INP}; EpiBranch<0> E{C.proj() + O_GATE, C.merged()}; REP(0) pg8::gemm_phase(lds, g, S, E); }
        { NEWCTX; pg8::Gemm g{C.qb(), C.w_br() + (size_t)1024 * 512, MTOK, 1024, 512, QW}; EpiBranch<1> E{C.proj() + O_GATE + 1024, C.merged()}; REP(0) pg8::gemm_phase(lds, g, S, E); }
        { NEWCTX; pg8::Gemm g{C.proj() + O_USGU, C.w_br() + (size_t)2 * 1024 * 512, MTOK, 1024, 512, INP}; EpiBranch<2> E{C.proj() + O_GATE + 2048, C.merged()}; REP(0) pg8::gemm_phase(lds, g, S, E); }
        GSYNC();
        { NEWCTX; const float* xres = (l == 0) ? C.in(0) : C.xcur();
          pg8::Gemm g{C.merged(), C.w_out(), MTOK, 1024, 1024, 1024}; EpiRes E{xres, C.pre(), C.ada() + (size_t)l * 4 * 6144 + 2048}; REP(0) pg8::gemm_phase(lds, g, S, E); }
        GSYNC();
        { NEWCTX; const float* ada_l = C.ada() + (size_t)l * 4 * 6144; REP(3) ln_pass(C.pre(), C.in(26) + l * 1024, C.in(27) + l * 1024, C.xcur(), C.hb(), ada_l + 3072, ada_l + 4096); }
        GSYNC();
        { NEWCTX; pg8::Gemm g{C.hb(), C.w_f1(), MTOK, FF2, 1024, 1024}; pg8::StaticOrder S2; S2.init(MTOK, FF2, G, cid); EpiFfn1 E{C.hid()}; REP(0) pg8::gemm_phase(lds, g, S2, E); }
        GSYNC();
        { NEWCTX; pg8::Gemm g{C.hid(), C.w_f2(), MTOK, 1024, FF, FF}; EpiRes E{C.xcur(), C.pre(), C.ada() + (size_t)l * 4 * 6144 + 5120}; REP(0) pg8::gemm_phase(lds, g, S, E); }
        GSYNC();
        if (l + 1 < DEPTH) {
            { NEWCTX; const float* ada_n = C.ada() + (size_t)(l + 1) * 4 * 6144; REP(3) ln_pass(C.pre(), C.in(30) + l * 1024, C.in(31) + l * 1024, C.xcur(), C.hb(), ada_n, ada_n + 1024); }
            __syncthreads();
            { NEWCTX;
#if !defined(NO_CONV)
              REP(4) convert_layer(C, l + 1, lds);
#endif
            }
        } else { NEWCTX; ln_pass(C.pre(), C.in(30) + l * 1024, C.in(31) + l * 1024, C.out(), nullptr, nullptr, nullptr); }
        GSYNC();
    }
}

extern "C" void kernel_launch(void* const* d_in, const int* in_sizes, int n_in, void* d_out, int out_size, void* d_ws, size_t ws_size, hipStream_t stream) {
    static int grid_blocks = 0;
    if (grid_blocks == 0) {
        if (n_in != 32 || out_size != MTOK * DM || ws_size < WS_END) { fprintf(stderr, "kernel_launch: unexpected problem (n_in %d out %d ws %zu need %zu)\n", n_in, out_size, ws_size, (size_t)WS_END); grid_blocks = -1; return; }
        int dev = 0, cus = 0, per_cu = 0;
        hipGetDevice(&dev);
        hipDeviceGetAttribute(&cus, hipDeviceAttributeMultiprocessorCount, dev);
        hipFuncSetAttribute((const void*)fwd_megakernel, hipFuncAttributeMaxDynamicSharedMemorySize, LDS_BYTES);
        hipOccupancyMaxActiveBlocksPerMultiprocessor(&per_cu, (const void*)fwd_megakernel, 512, LDS_BYTES);
        if (per_cu < 1) per_cu = 1;
        grid_blocks = cus * per_cu;
        (void)hipGetLastError();
    }
    if (grid_blocks < 0) return;
    (void)hipMemsetAsync((unsigned char*)d_ws + WS_BAR, 0, 16384, stream);
    Params p{};
    for (int i = 0; i < 32; ++i) p.in[i] = (const float*)d_in[i];
    p.out = (float*)d_out; p.ws = (unsigned char*)d_ws;
    void* args[] = {&p};
    hipError_t e = hipLaunchCooperativeKernel((const void*)fwd_megakernel, dim3(grid_blocks), dim3(512), args, LDS_BYTES, stream);
    if (e != hipSuccess) fprintf(stderr, "cooperative launch failed: %s (grid %d)\n", hipGetErrorString(e), grid_blocks);
}
```
